# Optimizing an MI355X kernel written in HIP

```python
import math
import jax, jax.numpy as jnp
from jax import lax
import numpy as np

D_MODEL = 1024
BATCH = 4
SEQ = 4096
DEPTH = 2

CHUNK = 64
Q_BLOCK = 128
HEAD_DIM = 64
FOX_HEADS = 8
FOX_DIM = FOX_HEADS * HEAD_DIM
GLA_HEADS = 4
GLA_DK = 64
GLA_DV = 128
GLA_QK = GLA_HEADS * GLA_DK
GLA_V = GLA_HEADS * GLA_DV
GLA_RANK = 16
GLA_TAU = 16.0
MIX_WIDTH = FOX_DIM + GLA_V
IN_COLS = 3 * FOX_DIM + FOX_HEADS + 2 * GLA_QK + 2 * GLA_V + GLA_RANK
S5_GROUP = 16
S5_GROUPS = D_MODEL // S5_GROUP
S5_STATE = 64
D_FF = 2816
N_EXPERTS = 8
TOP_K = 2
EXPERT_FF = 2816
N_EVEN = (DEPTH + 1) // 2
N_ODD = DEPTH // 2
EPS = 1e-6

kernel_name = "fox_gla_s5_moe_adaln_hybrid"


def rmsnorm(x, w):
    xf = x.astype(jnp.float32)
    y = xf * lax.rsqrt(jnp.mean(xf * xf, axis=-1, keepdims=True) + EPS)
    return y * w.astype(jnp.float32)


def adaln(c, w, b):
    m = jax.nn.silu(c.astype(jnp.float32)) @ w + b
    shift, scale, gate = jnp.split(m, 3, axis=-1)
    return shift[:, None, :], scale[:, None, :], gate[:, None, :]


def fox_attention(q, k, v, logf):
    B, H, S, dh = q.shape
    cum = jnp.cumsum(logf, axis=-1)
    nb = S // Q_BLOCK
    qb = q.reshape(B, H, nb, Q_BLOCK, dh).transpose(2, 0, 1, 3, 4)
    cb = cum.reshape(B, H, nb, Q_BLOCK).transpose(2, 0, 1, 3)
    kpos = jnp.arange(S)
    scale = dh ** -0.5

    def block(args):
        i, qi, ci = args
        s = jnp.einsum('bhqd,bhkd->bhqk', qi, k) * scale + ci[..., None] - cum[:, :, None, :]
        qpos = i * Q_BLOCK + jnp.arange(Q_BLOCK)
        s = jnp.where(kpos[None, :] <= qpos[:, None], s, -jnp.inf)
        p = jax.nn.softmax(s, axis=-1)
        return jnp.einsum('bhqk,bhkd->bhqd', p, v)

    out = lax.map(block, (jnp.arange(nb), qb, cb))
    return out.transpose(1, 2, 0, 3, 4).reshape(B, H, S, dh)


def gla_attention(q, k, v, log_a):
    B, H, S, dk = q.shape
    dv = v.shape[-1]
    nc = S // CHUNK

    def to_chunks(t):
        return t.reshape(B, H, nc, CHUNK, t.shape[-1]).transpose(2, 0, 1, 3, 4)

    qc, kc, vc, ac = (to_chunks(q * dk ** -0.5), to_chunks(k), to_chunks(v), to_chunks(log_a))
    bc = jnp.cumsum(ac, axis=3)
    causal = jnp.tril(jnp.ones((CHUNK, CHUNK), dtype=bool))

    def step(state, inp):
        qi, ki, vi, bi = inp
        diff = bi[:, :, :, None, :] - bi[:, :, None, :, :]
        decay = jnp.exp(jnp.where(causal[None, None, :, :, None], diff, -jnp.inf))
        attn = jnp.einsum('bhtd,bhsd,bhtsd->bhts', qi, ki, decay)
        o = (jnp.einsum('bhts,bhsv->bhtv', attn, vi)
             + jnp.einsum('bhtd,bhdv->bhtv', qi * jnp.exp(bi), state))
        blast = bi[:, :, -1:, :]
        state = (jnp.exp(blast[:, :, 0, :])[..., None] * state
                 + jnp.einsum('bhsd,bhsv->bhdv', ki * jnp.exp(blast - bi), vi))
        return state, o

    s0 = jnp.zeros((B, H, dk, dv), jnp.float32)
    _, o = lax.scan(step, s0, (qc, kc, vc, bc))
    return o.transpose(1, 2, 0, 3, 4).reshape(B, H, S, dv)


def even_mixer(h, w_in, fox_fb, gla_w2, gla_b2, gla_norm, w_o):
    B, S, _ = h.shape
    sizes = (FOX_DIM, FOX_DIM, FOX_DIM, FOX_HEADS, GLA_QK, GLA_QK, GLA_V, GLA_V, GLA_RANK)
    cuts = [sum(sizes[:i + 1]) for i in range(len(sizes) - 1)]
    fq, fk, fv, ff, gq, gk, gv, gg, glr = jnp.split(h @ w_in, cuts, axis=-1)

    def heads(t, n):
        return t.reshape(B, S, n, -1).transpose(0, 2, 1, 3)

    logf = jax.nn.log_sigmoid(ff + fox_fb).transpose(0, 2, 1)
    fox = fox_attention(heads(fq, FOX_HEADS), heads(fk, FOX_HEADS), heads(fv, FOX_HEADS), logf)
    fox = fox.transpose(0, 2, 1, 3).reshape(B, S, FOX_DIM)
    log_a = jax.nn.log_sigmoid(glr @ gla_w2 + gla_b2) / GLA_TAU
    gla = gla_attention(heads(gq, GLA_HEADS), heads(gk, GLA_HEADS), heads(gv, GLA_HEADS),
                        heads(log_a, GLA_HEADS))
    gla = rmsnorm(gla.transpose(0, 2, 1, 3), gla_norm).reshape(B, S, GLA_V) * jax.nn.silu(gg)
    return jnp.concatenate([fox, gla], axis=-1) @ w_o


def s5_mixer(h, w_in, lam_re, lam_im, log_dt, b_re, b_im, c_re, c_im, d_skip, w_glu, w_o):
    B, S, _ = h.shape
    f32 = jnp.float32
    lam_re, lam_im, log_dt = lam_re.astype(f32), lam_im.astype(f32), log_dt.astype(f32)
    b_re, b_im, c_re, c_im = b_re.astype(f32), b_im.astype(f32), c_re.astype(f32), c_im.astype(f32)
    u = h @ w_in
    ug = u.reshape(B, S, S5_GROUPS, S5_GROUP)
    dt = jnp.exp(log_dt)[:, None]
    mag = jnp.exp(lam_re * dt)
    a_re = mag * jnp.cos(lam_im * dt)
    a_im = mag * jnp.sin(lam_im * dt)
    den = lam_re * lam_re + lam_im * lam_im
    nr, ni = a_re - 1.0, a_im
    f_re = (nr * lam_re + ni * lam_im) / den
    f_im = (ni * lam_re - nr * lam_im) / den
    bb_re = f_re[..., None] * b_re - f_im[..., None] * b_im
    bb_im = f_re[..., None] * b_im + f_im[..., None] * b_re
    ut = ug.transpose(1, 0, 2, 3)
    bu_re = jnp.einsum('sbgk,gpk->sbgp', ut, bb_re)
    bu_im = jnp.einsum('sbgk,gpk->sbgp', ut, bb_im)
    ar_t = jnp.broadcast_to(a_re[None, None], (S, 1, S5_GROUPS, S5_STATE))
    ai_t = jnp.broadcast_to(a_im[None, None], (S, 1, S5_GROUPS, S5_STATE))

    def combine(e1, e2):
        a1r, a1i, b1r, b1i = e1
        a2r, a2i, b2r, b2i = e2
        return (a1r * a2r - a1i * a2i,
                a1r * a2i + a1i * a2r,
                a2r * b1r - a2i * b1i + b2r,
                a2r * b1i + a2i * b1r + b2i)

    _, _, xr, xi = lax.associative_scan(combine, (ar_t, ai_t, bu_re, bu_im), axis=0)
    y = jnp.einsum('sbgp,gkp->bsgk', xr, c_re) - jnp.einsum('sbgp,gkp->bsgk', xi, c_im)
    y = y.reshape(B, S, D_MODEL) + d_skip * u
    y = jax.nn.gelu(y)
    y = y * jax.nn.sigmoid(y @ w_glu)
    return y @ w_o


def swiglu(h, w_gate, w_up, w_down):
    return (jax.nn.silu(h @ w_gate) * (h @ w_up)) @ w_down


def moe_swiglu(h, w_router, w_gate, w_up, w_down):
    logits = (h @ w_router).astype(jnp.float32)
    top_val, top_idx = lax.top_k(logits, TOP_K)
    weights = jax.nn.softmax(top_val, axis=-1)
    gates = jnp.sum(jax.nn.one_hot(top_idx, N_EXPERTS, dtype=jnp.float32) * weights[..., None], axis=-2)
    out = jnp.zeros_like(h)
    for e in range(N_EXPERTS):
        out = out + gates[..., e:e + 1] * swiglu(h, w_gate[e], w_up[e], w_down[e])
    return out


def setup_inputs(seed: int = 0) -> dict:
    key = jax.random.key(seed)
    ks = iter(jax.random.split(key, 64))
    f32 = jnp.float32

    def nrm(shape, scale):
        return jax.random.normal(next(ks), shape, f32) * scale

    def gain(shape):
        return 1.0 + 0.05 * jax.random.normal(next(ks), shape, f32)

    D = D_MODEL
    NE, NO = N_EVEN, N_ODD
    G, P, K = S5_GROUPS, S5_STATE, S5_GROUP
    mod_s = 0.5 * D ** -0.5
    inp = {}
    inp['x'] = nrm((BATCH, SEQ, D), 1.0)
    inp['c'] = nrm((BATCH, D), 1.0)
    inp['e_norm_mix'] = gain((NE, D))
    inp['e_mod_mix_w'] = nrm((NE, D, 3 * D), mod_s)
    inp['e_mod_mix_b'] = nrm((NE, 3 * D), 0.02)
    inp['e_w_in'] = nrm((NE, D, IN_COLS), D ** -0.5)
    inp['e_fox_fb'] = 2.0 + nrm((NE, FOX_HEADS), 0.5)
    inp['e_gla_w2'] = nrm((NE, GLA_RANK, GLA_QK), GLA_RANK ** -0.5)
    inp['e_gla_b2'] = nrm((NE, GLA_QK), 0.02)
    inp['e_gla_norm'] = gain((NE, GLA_DV))
    inp['e_w_o'] = nrm((NE, MIX_WIDTH, D), MIX_WIDTH ** -0.5)
    inp['e_norm_ffn'] = gain((NE, D))
    inp['e_mod_ffn_w'] = nrm((NE, D, 3 * D), mod_s)
    inp['e_mod_ffn_b'] = nrm((NE, 3 * D), 0.02)
    inp['e_ffn_gate'] = nrm((NE, D, D_FF), D ** -0.5)
    inp['e_ffn_up'] = nrm((NE, D, D_FF), D ** -0.5)
    inp['e_ffn_down'] = nrm((NE, D_FF, D), D_FF ** -0.5)
    inp['o_norm_mix'] = gain((NO, D))
    inp['o_mod_mix_w'] = nrm((NO, D, 3 * D), mod_s)
    inp['o_mod_mix_b'] = nrm((NO, 3 * D), 0.02)
    inp['o_w_in'] = nrm((NO, D, D), D ** -0.5)
    inp['o_lam_re'] = -0.5 + nrm((NO, G, P), 0.01)
    inp['o_lam_im'] = math.pi * jnp.arange(P, dtype=f32)[None, None, :] + nrm((NO, G, P), 0.01)
    inp['o_log_dt'] = jax.random.uniform(next(ks), (NO, G), f32, math.log(1e-3), math.log(1e-1))
    inp['o_b_re'] = nrm((NO, G, P, K), (2.0 * K) ** -0.5)
    inp['o_b_im'] = nrm((NO, G, P, K), (2.0 * K) ** -0.5)
    inp['o_c_re'] = nrm((NO, G, K, P), (2.0 / P) ** 0.5)
    inp['o_c_im'] = nrm((NO, G, K, P), (2.0 / P) ** 0.5)
    inp['o_d_skip'] = nrm((NO, D), 1.0)
    inp['o_w_glu'] = nrm((NO, D, D), D ** -0.5)
    inp['o_w_o'] = nrm((NO, D, D), D ** -0.5)
    inp['o_norm_ffn'] = gain((NO, D))
    inp['o_mod_ffn_w'] = nrm((NO, D, 3 * D), mod_s)
    inp['o_mod_ffn_b'] = nrm((NO, 3 * D), 0.02)
    inp['o_router'] = nrm((NO, D, N_EXPERTS), D ** -0.5)
    inp['o_exp_gate'] = nrm((NO, N_EXPERTS, D, EXPERT_FF), D ** -0.5)
    inp['o_exp_up'] = nrm((NO, N_EXPERTS, D, EXPERT_FF), D ** -0.5)
    inp['o_exp_down'] = nrm((NO, N_EXPERTS, EXPERT_FF, D), EXPERT_FF ** -0.5)
    inp['final_norm'] = gain((D,))
    return inp


def reference(x, c,
              e_norm_mix, e_mod_mix_w, e_mod_mix_b, e_w_in, e_fox_fb, e_gla_w2, e_gla_b2,
              e_gla_norm, e_w_o, e_norm_ffn, e_mod_ffn_w, e_mod_ffn_b, e_ffn_gate, e_ffn_up,
              e_ffn_down,
              o_norm_mix, o_mod_mix_w, o_mod_mix_b, o_w_in, o_lam_re, o_lam_im, o_log_dt,
              o_b_re, o_b_im, o_c_re, o_c_im, o_d_skip, o_w_glu, o_w_o, o_norm_ffn,
              o_mod_ffn_w, o_mod_ffn_b, o_router, o_exp_gate, o_exp_up, o_exp_down,
              final_norm):
    for i in range(DEPTH):
        j = i // 2
        if i % 2 == 0:
            sh, sc, g = adaln(c, e_mod_mix_w[j], e_mod_mix_b[j])
            h = rmsnorm(x, e_norm_mix[j]) * (1.0 + sc) + sh
            y = even_mixer(h, e_w_in[j], e_fox_fb[j], e_gla_w2[j], e_gla_b2[j], e_gla_norm[j], e_w_o[j])
            x = x + (g * y).astype(x.dtype)
            sh, sc, g = adaln(c, e_mod_ffn_w[j], e_mod_ffn_b[j])
            h = rmsnorm(x, e_norm_ffn[j]) * (1.0 + sc) + sh
            y = swiglu(h, e_ffn_gate[j], e_ffn_up[j], e_ffn_down[j])
            x = x + (g * y).astype(x.dtype)
        else:
            sh, sc, g = adaln(c, o_mod_mix_w[j], o_mod_mix_b[j])
            h = rmsnorm(x, o_norm_mix[j]) * (1.0 + sc) + sh
            y = s5_mixer(h, o_w_in[j], o_lam_re[j], o_lam_im[j], o_log_dt[j], o_b_re[j], o_b_im[j],
                         o_c_re[j], o_c_im[j], o_d_skip[j], o_w_glu[j], o_w_o[j])
            x = x + (g * y).astype(x.dtype)
            sh, sc, g = adaln(c, o_mod_ffn_w[j], o_mod_ffn_b[j])
            h = rmsnorm(x, o_norm_ffn[j]) * (1.0 + sc) + sh
            y = moe_swiglu(h, o_router[j], o_exp_gate[j], o_exp_up[j], o_exp_down[j])
            x = x + (g * y).astype(x.dtype)
    return rmsnorm(x, final_norm).astype(x.dtype)
```

```cpp
#define MK_LAUNCH_PER_PHASE 0
#define MK_STAGE 4
#include <hip/hip_runtime.h>
#include <hip/hip_bf16.h>
#include <cstdio>
#include <cstdint>
#include <cmath>

#define LAS __attribute__((address_space(3)))
#define GAS __attribute__((address_space(1)))
typedef unsigned short bf16_t;
typedef short bf16x8 __attribute__((ext_vector_type(8)));
typedef float f32x4 __attribute__((ext_vector_type(4)));
typedef float f32x2 __attribute__((ext_vector_type(2)));
typedef float f32x16 __attribute__((ext_vector_type(16)));
typedef unsigned u32x4 __attribute__((ext_vector_type(4)));
typedef unsigned u32x2 __attribute__((ext_vector_type(2)));

__device__ __forceinline__ unsigned cvt_pk_bf16(float lo, float hi) { unsigned r; asm volatile("v_cvt_pk_bf16_f32 %0, %1, %2" : "=v"(r) : "v"(lo), "v"(hi)); return r; }
__device__ __forceinline__ float bf_lo(unsigned w) { return __uint_as_float(w << 16); }
__device__ __forceinline__ float bf_hi(unsigned w) { return __uint_as_float(w & 0xffff0000u); }
__device__ __forceinline__ float fast_exp(float x) { return __builtin_amdgcn_exp2f(x * 1.4426950408889634f); }
__device__ __forceinline__ float fast_sigmoid(float x) { return __builtin_amdgcn_rcpf(1.0f + fast_exp(-x)); }
__device__ __forceinline__ float silu_f(float x) { return x * fast_sigmoid(x); }
__device__ __forceinline__ float gelu_tanh_f(float y) { const float t = 1.5957691216057308f * (y + 0.044715f * y * y * y); return y * fast_sigmoid(t); }

namespace pg8 {
constexpr int BM = 256, BK = 64, HALF = 128, HTB = HALF * BK * 2, STAGE_BYTES = 8 * HTB, NXCD = 8, WGM = 8;
__host__ __device__ __forceinline__ int lds_byte(int r, int c) { const int st = (r >> 4) * 2 + (c >> 5), rr = r & 15, cc = c & 31, ob = rr * 64 + cc * 2; return st * 1024 + (ob ^ (((ob >> 9) & 1) << 5)); }
__host__ __device__ __forceinline__ void stage_rc(int b, int& R, int& C) { const int st = b / 1024, sb = b % 1024, swz = sb ^ (((sb >> 9) & 1) << 5); R = (st >> 1) * 16 + swz / 64; C = (st & 1) * 32 + (swz % 64) / 2; }
__host__ __device__ __forceinline__ int perm32(int rho) { const int n = rho >> 4, i = rho & 15; return 8 * (i >> 2) + 4 * n + (i & 3); }

struct Unit { int pm, pn, bt; };
struct Gemm { const bf16_t* A; const bf16_t* Bt; int lda, K; size_t sA, sB; };

struct StaticOrder {
    int nM, nN, nwg, G, c;
    __device__ __forceinline__ void init(int nM_, int nN_, int nb, int G_, int c_) { nM = nM_; nN = nN_; nwg = nM * nN * nb; G = G_; c = c_; }
    __device__ __forceinline__ bool next(int i, Unit& u) const {
        const long L = (long)i * G + c; if (L >= nwg) return false;
        int wgid = (int)L; { const int q = nwg / NXCD, r = nwg % NXCD, xcd = wgid % NXCD, off = wgid / NXCD; wgid = (xcd < r ? xcd * (q + 1) : r * (q + 1) + (xcd - r) * q) + off; }
        const int per = nM * nN; u.bt = wgid / per; wgid -= u.bt * per;
        const int nig = WGM * nN, gid = wgid / nig, fm = gid * WGM, gsz = (nM - fm) < WGM ? (nM - fm) : WGM;
        u.pm = fm + ((wgid % nig) % gsz); u.pn = (wgid % nig) / gsz; return true;
    }
};
struct MoeOrder {
    int nN, nwg, G, c, nM; int ts[9];
    __device__ __forceinline__ void init(const int* tstart, int nN_, int G_, int c_) {
#pragma unroll
        for (int e = 0; e < 9; ++e) ts[e] = tstart[e];
        nM = ts[8]; nN = nN_; nwg = nM * nN; G = G_; c = c_; }
    __device__ __forceinline__ bool next(int i, Unit& u) const {
        const long L = (long)i * G + c; if (L >= nwg) return false;
        int wgid = (int)L; { const int q = nwg / NXCD, r = nwg % NXCD, xcd = wgid % NXCD, off = wgid / NXCD; wgid = (xcd < r ? xcd * (q + 1) : r * (q + 1) + (xcd - r) * q) + off; }
        const int nig = WGM * nN, gid = wgid / nig, fm = gid * WGM, gsz = (nM - fm) < WGM ? (nM - fm) : WGM;
        u.pm = fm + ((wgid % nig) % gsz); u.pn = (wgid % nig) / gsz;
        int e = 0;
#pragma unroll
        for (int k = 1; k < 8; ++k) e += (u.pm >= ts[k]) ? 1 : 0;
        u.bt = e; return true;
    }
};

template <class Epi, class Sched, bool ALIGN_EPI, bool GATHER>
__device__ __forceinline__ void gemm_phase(LAS unsigned char* lds, const Gemm g, const Sched& S, const Epi& E, const LAS unsigned* gtab) {
    const int tid = threadIdx.x, wid = __builtin_amdgcn_readfirstlane(tid >> 6), lane = tid & 63, wr = wid >> 2, wc = wid & 3, fr = lane & 15, fq = lane >> 4;
    const int K = g.K, nt = K / BK, lda = g.lda;
    unsigned voffB[2], oA[2][2], oN[2][2]; int Rr[2], Cc[2];
    const size_t hstepA = (size_t)HALF * lda * 2, hstepB = (size_t)HALF * K * 2;
#pragma unroll
    for (int i = 0; i < 2; ++i) { int R, C; stage_rc(tid * 16 + i * 8192, R, C); const int Rb = Epi::PERM ? ((R & ~31) + perm32(R & 31)) : R; Rr[i] = R; Cc[i] = C;
        voffB[i] = (unsigned)(Rb * K + C) * 2u; oA[0][i] = (unsigned)(R * lda + C) * 2u; oA[1][i] = oA[0][i] + (unsigned)hstepA; oN[0][i] = oA[0][i]; oN[1][i] = oA[1][i]; }
    const size_t kstep = (size_t)(BK * 2);
    const size_t tstepA = 2 * hstepA, tstepB = 2 * hstepB;
    const unsigned ldsw = (unsigned)wid * 1024u;
    const int aoff = lds_byte(wr * 64 + fr, fq * 8), boff = lds_byte(wc * 32 + fr, fq * 8);
#define PG8_SA(b, h) (((b) * 2 + (h)) * HTB)
#define PG8_SB(b, h) ((4 + (b) * 2 + (h)) * HTB)
#define PG8_STAGE(bufoff, gbase, voff) do { _Pragma("unroll") for (int _i = 0; _i < 2; ++_i) \
        __builtin_amdgcn_global_load_lds((const unsigned*)((const char*)(gbase) + (voff)[_i]), (LAS unsigned*)(lds + (bufoff) + ldsw + _i * 8192), 16, 0, 0); } while (0)
#define PG8_LDA(dst, b, h) do { _Pragma("unroll") for (int m = 0; m < 4; ++m) _Pragma("unroll") for (int k = 0; k < 2; ++k) dst[m][k] = *(const LAS bf16x8*)(lds + PG8_SA(b, h) + aoff + m * 2048 + k * 1024); } while (0)
#define PG8_LDB(dst, b, h) do { _Pragma("unroll") for (int n = 0; n < 2; ++n) _Pragma("unroll") for (int k = 0; k < 2; ++k) dst[n][k] = *(const LAS bf16x8*)(lds + PG8_SB(b, h) + boff + n * 2048 + k * 1024); } while (0)
#define PG8_MMA(ai, bj, At, Bt) do { __builtin_amdgcn_s_setprio(1); _Pragma("unroll") for (int m = 0; m < 4; ++m) _Pragma("unroll") for (int n = 0; n < 2; ++n) _Pragma("unroll") for (int k = 0; k < 2; ++k) \
        acc[ai][bj][m][n] = __builtin_amdgcn_mfma_f32_16x16x32_bf16(Bt[n][k], At[m][k], acc[ai][bj][m][n], 0, 0, 0); __builtin_amdgcn_s_setprio(0); } while (0)
#define PG8_WAIT_V(n) asm volatile("s_waitcnt vmcnt(" #n ")" ::: "memory")
#define PG8_WAIT_L(n) asm volatile("s_waitcnt lgkmcnt(" #n ")" ::: "memory")
#define PG8_BAR __builtin_amdgcn_s_barrier()
#define PG8_SCHED __builtin_amdgcn_sched_barrier(0)
#define PG8_GOFF(dst, ord) do { if constexpr (GATHER) { _Pragma("unroll") for (int _h = 0; _h < 2; ++_h) _Pragma("unroll") for (int _i = 0; _i < 2; ++_i) dst[_h][_i] = gtab[(ord) * 256 + Rr[_i] + 128 * _h] + (unsigned)Cc[_i] * 2u; } } while (0)
    Unit cur, nxt; int ui = 0;
    if (!S.next(0, cur)) return;
    f32x4 acc[2][2][4][2];
#pragma unroll
    for (int a = 0; a < 2; ++a)
#pragma unroll
        for (int b = 0; b < 2; ++b)
#pragma unroll
            for (int m = 0; m < 4; ++m)
#pragma unroll
                for (int n = 0; n < 2; ++n) acc[a][b][m][n] = (f32x4){0.f, 0.f, 0.f, 0.f};
    bf16x8 At[4][2], B0[2][2], B1[2][2];
    const char* cA = (const char*)g.A + (GATHER ? (size_t)0 : ((size_t)cur.bt * g.sA * 2 + (size_t)cur.pm * tstepA));
    const char* cB = (const char*)g.Bt + (size_t)cur.bt * g.sB * 2 + (size_t)cur.pn * tstepB;
    PG8_GOFF(oA, 0);
    PG8_STAGE(PG8_SB(0, 0), cB, voffB); PG8_STAGE(PG8_SB(0, 1), cB + hstepB, voffB); PG8_STAGE(PG8_SA(0, 0), cA, oA[0]); PG8_STAGE(PG8_SA(0, 1), cA, oA[1]);
    if (wr == 1) PG8_BAR;
    PG8_WAIT_V(2); PG8_BAR;
    PG8_STAGE(PG8_SB(1, 0), cB + kstep, voffB); PG8_STAGE(PG8_SA(1, 0), cA + kstep, oA[0]); PG8_STAGE(PG8_SB(1, 1), cB + hstepB + kstep, voffB);
    PG8_WAIT_V(6); PG8_BAR;
    for (;;) {
        const bool has_next = S.next(ui + 1, nxt);
        const char* nA = has_next ? ((const char*)g.A + (GATHER ? (size_t)0 : ((size_t)nxt.bt * g.sA * 2 + (size_t)nxt.pm * tstepA))) : cA;
        const char* nB = has_next ? (const char*)g.Bt + (size_t)nxt.bt * g.sB * 2 + (size_t)nxt.pn * tstepB : cB;
        if constexpr (GATHER) { if (has_next) { PG8_GOFF(oN, ui + 1); } else {
#pragma unroll
            for (int _h = 0; _h < 2; ++_h)
#pragma unroll
                for (int _i = 0; _i < 2; ++_i) oN[_h][_i] = oA[_h][_i]; } }
        for (int t = 0; t < nt; t += 2) {
            const bool last = (t == nt - 2);
            const char* a1 = cA + (size_t)(t + 1) * kstep;
            const char* a2 = last ? nA : cA + (size_t)(t + 2) * kstep; const char* b2 = last ? nB : cB + (size_t)(t + 2) * kstep;
            const char* a3 = a2 + kstep; const char* b3 = b2 + kstep;
            unsigned o2[2][2];
#pragma unroll
            for (int _h = 0; _h < 2; ++_h)
#pragma unroll
                for (int _i = 0; _i < 2; ++_i) o2[_h][_i] = (GATHER && last) ? oN[_h][_i] : oA[_h][_i];
            PG8_LDB(B0, 0, 0); PG8_LDB(B1, 0, 1); PG8_SCHED; PG8_LDA(At, 0, 0); PG8_STAGE(PG8_SA(1, 1), a1, oA[1]);
            PG8_WAIT_V(8); PG8_WAIT_L(0); PG8_BAR; PG8_MMA(0, 0, At, B0); PG8_MMA(0, 1, At, B1); PG8_BAR; PG8_SCHED;
            PG8_LDA(At, 0, 1); PG8_STAGE(PG8_SB(0, 0), b2, voffB); PG8_STAGE(PG8_SB(0, 1), b2 + hstepB, voffB); PG8_STAGE(PG8_SA(0, 0), a2, o2[0]);
            PG8_WAIT_V(8); PG8_WAIT_L(0); PG8_BAR; PG8_MMA(1, 0, At, B0); PG8_MMA(1, 1, At, B1); PG8_BAR; PG8_SCHED;
            PG8_LDB(B0, 1, 0); PG8_LDB(B1, 1, 1); PG8_SCHED; PG8_LDA(At, 1, 0); PG8_STAGE(PG8_SA(0, 1), a2, o2[1]);
            PG8_WAIT_V(8); PG8_WAIT_L(0); PG8_BAR; PG8_MMA(0, 0, At, B0); PG8_MMA(0, 1, At, B1); PG8_BAR; PG8_SCHED;
            PG8_LDA(At, 1, 1); PG8_STAGE(PG8_SB(1, 0), b3, voffB); PG8_STAGE(PG8_SB(1, 1), b3 + hstepB, voffB); PG8_STAGE(PG8_SA(1, 0), a3, o2[0]);
            PG8_WAIT_V(8); PG8_WAIT_L(0); PG8_BAR; PG8_MMA(1, 0, At, B0); PG8_MMA(1, 1, At, B1); PG8_BAR; PG8_SCHED;
        }
        if constexpr (ALIGN_EPI) { if (wr == 0) PG8_BAR; }
        E(acc, cur, wr, wc, fr, fq);
        if (!has_next) break;
#pragma unroll
        for (int a = 0; a < 2; ++a)
#pragma unroll
            for (int b = 0; b < 2; ++b)
#pragma unroll
                for (int m = 0; m < 4; ++m)
#pragma unroll
                    for (int n = 0; n < 2; ++n) acc[a][b][m][n] = (f32x4){0.f, 0.f, 0.f, 0.f};
        cur = nxt; cA = nA; cB = nB; ++ui;
        if constexpr (GATHER) {
#pragma unroll
            for (int _h = 0; _h < 2; ++_h)
#pragma unroll
                for (int _i = 0; _i < 2; ++_i) oA[_h][_i] = oN[_h][_i]; }
        if constexpr (ALIGN_EPI) { if (wr == 1) PG8_BAR; }
    }
    PG8_WAIT_V(0);
    if constexpr (!ALIGN_EPI) { if (wr == 0) PG8_BAR; }
    PG8_BAR;
#undef PG8_SA
#undef PG8_SB
#undef PG8_STAGE
#undef PG8_LDA
#undef PG8_LDB
#undef PG8_MMA
#undef PG8_WAIT_V
#undef PG8_WAIT_L
#undef PG8_BAR
#undef PG8_SCHED
#undef PG8_GOFF
}
}
namespace pg8 {
struct EpiBf16 {
    static constexpr bool PERM = true;
    bf16_t* O; int ldc; int nscale; float scale;
    __device__ __forceinline__ void operator()(const f32x4 (&acc)[2][2][4][2], const Unit& u, int wr, int wc, int fr, int fq) const {
        const int row0 = u.pm * BM + wr * 64 + fr, col0 = u.pn * BM + wc * 32 + 8 * fq; const float sc = (u.pn < nscale) ? scale : 1.f;
#pragma unroll
        for (int ai = 0; ai < 2; ++ai)
#pragma unroll
            for (int m = 0; m < 4; ++m) { bf16_t* rowp = O + (size_t)(row0 + ai * HALF + m * 16) * ldc + col0;
#pragma unroll
                for (int bj = 0; bj < 2; ++bj) { const f32x4 v0 = acc[ai][bj][m][0] * sc, v1 = acc[ai][bj][m][1] * sc;
                    u32x4 w; w.x = cvt_pk_bf16(v0[0], v0[1]); w.y = cvt_pk_bf16(v0[2], v0[3]); w.z = cvt_pk_bf16(v1[0], v1[1]); w.w = cvt_pk_bf16(v1[2], v1[3]);
                    *(u32x4*)(rowp + bj * HALF) = w; } }
    }
};
struct EpiSwiGLU {
    static constexpr bool PERM = true;
    bf16_t* O; int ldc;
    __device__ __forceinline__ void operator()(const f32x4 (&acc)[2][2][4][2], const Unit& u, int wr, int wc, int fr, int fq) const {
        const int row0 = u.pm * BM + wr * 64 + fr, col0 = u.pn * HALF + wc * 32 + 8 * fq;
#pragma unroll
        for (int ai = 0; ai < 2; ++ai)
#pragma unroll
            for (int m = 0; m < 4; ++m) { bf16_t* rowp = O + (size_t)(row0 + ai * HALF + m * 16) * ldc + col0;
                float r[8];
#pragma unroll
                for (int n = 0; n < 2; ++n)
#pragma unroll
                    for (int j = 0; j < 4; ++j) { const float gt = acc[ai][0][m][n][j], up = acc[ai][1][m][n][j]; r[n * 4 + j] = silu_f(gt) * up; }
                u32x4 w; w.x = cvt_pk_bf16(r[0], r[1]); w.y = cvt_pk_bf16(r[2], r[3]); w.z = cvt_pk_bf16(r[4], r[5]); w.w = cvt_pk_bf16(r[6], r[7]);
                *(u32x4*)rowp = w; }
    }
};
struct EpiResid {
    static constexpr bool PERM = false;
    const float* base; float* out; const float* gate;
    __device__ __forceinline__ void operator()(const f32x4 (&acc)[2][2][4][2], const Unit& u, int wr, int wc, int fr, int fq) const {
        const int row0 = u.pm * BM + wr * 64 + fr, col0 = u.pn * BM + wc * 32 + 4 * fq; const float* gv = gate + (size_t)(u.pm >> 4) * 3072;
#pragma unroll
        for (int bj = 0; bj < 2; ++bj)
#pragma unroll
            for (int n = 0; n < 2; ++n) { const int col = col0 + bj * HALF + n * 16; const f32x4 gg = *(const f32x4*)(gv + col);
#pragma unroll
                for (int ai = 0; ai < 2; ++ai)
#pragma unroll
                    for (int m = 0; m < 4; ++m) { const size_t off = (size_t)(row0 + ai * HALF + m * 16) * 1024 + col;
                        const f32x4 bs = *(const f32x4*)(base + off); *(f32x4*)(out + off) = bs + gg * acc[ai][bj][m][n]; } }
    }
};
struct EpiS5U {
    static constexpr bool PERM = true;
    bf16_t* AU;
    __device__ __forceinline__ void operator()(const f32x4 (&acc)[2][2][4][2], const Unit& u, int wr, int wc, int fr, int fq) const {
        const int row0 = u.pm * BM + wr * 64 + fr, col0 = u.pn * BM + wc * 32 + 8 * fq;
#pragma unroll
        for (int ai = 0; ai < 2; ++ai)
#pragma unroll
            for (int m = 0; m < 4; ++m) { const int tok = row0 + ai * HALF + m * 16;
#pragma unroll
                for (int bj = 0; bj < 2; ++bj) { const int c8 = col0 + bj * HALF, gi = c8 >> 4, k0 = c8 & 15; const f32x4 v0 = acc[ai][bj][m][0], v1 = acc[ai][bj][m][1];
                    u32x4 w; w.x = cvt_pk_bf16(v0[0], v0[1]); w.y = cvt_pk_bf16(v0[2], v0[3]); w.z = cvt_pk_bf16(v1[0], v1[1]); w.w = cvt_pk_bf16(v1[2], v1[3]);
                    *(u32x4*)(AU + ((size_t)(gi * 512 + (tok >> 5)) * 640 + (tok & 31) * 16 + k0)) = w; } }
    }
};
struct EpiS5E {
    static constexpr bool PERM = false;
    float* E;
    __device__ __forceinline__ void operator()(const f32x4 (&acc)[2][2][4][2], const Unit& u, int wr, int wc, int fr, int fq) const {
        const int row0 = u.pm * BM + wr * 64 + fr, col0 = wc * 32 + 4 * fq;
#pragma unroll
        for (int ai = 0; ai < 2; ++ai)
#pragma unroll
            for (int m = 0; m < 4; ++m)
#pragma unroll
                for (int n = 0; n < 2; ++n) *(f32x4*)(E + ((size_t)(u.bt * 512 + row0 + ai * HALF + m * 16) * 128 + col0 + n * 16)) = acc[ai][0][m][n];
    }
};
struct EpiS5Y {
    static constexpr bool PERM = true;
    const bf16_t* AU; const float* dskip; bf16_t* YG;
    __device__ __forceinline__ void operator()(const f32x4 (&acc)[2][2][4][2], const Unit& u, int wr, int wc, int fr, int fq) const {
        const int row0 = u.pm * BM + wr * 64 + fr, col0 = u.pn * BM + wc * 32 + 8 * fq;
#pragma unroll
        for (int bj = 0; bj < 2; ++bj) { const int c8 = col0 + bj * HALF, ii = c8 >> 4, k0 = c8 & 15, ch = u.bt * 16 + k0;
            const f32x4 d0 = *(const f32x4*)(dskip + ch), d1 = *(const f32x4*)(dskip + ch + 4);
#pragma unroll
            for (int ai = 0; ai < 2; ++ai)
#pragma unroll
                for (int m = 0; m < 4; ++m) { const int row = row0 + ai * HALF + m * 16;
                    const u32x4 uu = *(const u32x4*)(AU + ((size_t)(u.bt * 512 + row) * 640 + c8));
                    const f32x4 v0 = acc[ai][bj][m][0], v1 = acc[ai][bj][m][1];
                    float r[8];
                    r[0] = v0[0] + d0[0] * bf_lo(uu.x); r[1] = v0[1] + d0[1] * bf_hi(uu.x); r[2] = v0[2] + d0[2] * bf_lo(uu.y); r[3] = v0[3] + d0[3] * bf_hi(uu.y);
                    r[4] = v1[0] + d1[0] * bf_lo(uu.z); r[5] = v1[1] + d1[1] * bf_hi(uu.z); r[6] = v1[2] + d1[2] * bf_lo(uu.w); r[7] = v1[3] + d1[3] * bf_hi(uu.w);
#pragma unroll
                    for (int j = 0; j < 8; ++j) r[j] = gelu_tanh_f(r[j]);
                    u32x4 w; w.x = cvt_pk_bf16(r[0], r[1]); w.y = cvt_pk_bf16(r[2], r[3]); w.z = cvt_pk_bf16(r[4], r[5]); w.w = cvt_pk_bf16(r[6], r[7]);
                    *(u32x4*)(YG + ((size_t)(row * 32 + ii) * 1024 + ch)) = w; } }
    }
};
struct EpiGlu {
    static constexpr bool PERM = true;
    const bf16_t* YG; bf16_t* Z;
    __device__ __forceinline__ void operator()(const f32x4 (&acc)[2][2][4][2], const Unit& u, int wr, int wc, int fr, int fq) const {
        const int row0 = u.pm * BM + wr * 64 + fr, col0 = u.pn * BM + wc * 32 + 8 * fq;
#pragma unroll
        for (int ai = 0; ai < 2; ++ai)
#pragma unroll
            for (int m = 0; m < 4; ++m) { const size_t ro = (size_t)(row0 + ai * HALF + m * 16) * 1024 + col0;
#pragma unroll
                for (int bj = 0; bj < 2; ++bj) { const u32x4 yy = *(const u32x4*)(YG + ro + bj * HALF); const f32x4 v0 = acc[ai][bj][m][0], v1 = acc[ai][bj][m][1];
                    float r[8];
                    r[0] = bf_lo(yy.x) * fast_sigmoid(v0[0]); r[1] = bf_hi(yy.x) * fast_sigmoid(v0[1]); r[2] = bf_lo(yy.y) * fast_sigmoid(v0[2]); r[3] = bf_hi(yy.y) * fast_sigmoid(v0[3]);
                    r[4] = bf_lo(yy.z) * fast_sigmoid(v1[0]); r[5] = bf_hi(yy.z) * fast_sigmoid(v1[1]); r[6] = bf_lo(yy.w) * fast_sigmoid(v1[2]); r[7] = bf_hi(yy.w) * fast_sigmoid(v1[3]);
                    u32x4 w; w.x = cvt_pk_bf16(r[0], r[1]); w.y = cvt_pk_bf16(r[2], r[3]); w.z = cvt_pk_bf16(r[4], r[5]); w.w = cvt_pk_bf16(r[6], r[7]);
                    *(u32x4*)(Z + ro + bj * HALF) = w; } }
    }
};
}
namespace attn_body {
using bf16=__hip_bfloat16;
using bf16x8=__attribute__((ext_vector_type(8)))short;
using s16x4=__attribute__((ext_vector_type(4)))short;
using f32x16=__attribute__((ext_vector_type(16)))float;
using u32x4=__attribute__((ext_vector_type(4)))unsigned;
using f32x4v=__attribute__((ext_vector_type(4)))float;
constexpr int BATCH=4,NHEAD=8,SEQ=4096,D=64,PQ=3072,PO=1024;
constexpr int NW=8,QBLK=32,QB=QBLK*NW,KVBLK=64,NQB=SEQ/QB;
constexpr int ATTN_UNIT_ROWS=QB;
__device__ __forceinline__ int crow(int r,int hi){return (r&3)+8*(r>>2)+4*hi;}
#define SBAR() __builtin_amdgcn_sched_barrier(0)
__device__ __forceinline__ void cmask(f32x16&p0,f32x16&p1,int jb,int qrel,int hi){
  const float NEG=-INFINITY; int kb=64*jb+4*hi;
  #pragma unroll
  for(int r=0;r<16;++r){int kv=kb+(r&3)+8*(r>>2); if(kv>qrel)p0[r]=NEG; if(kv+32>qrel)p1[r]=NEG;}
}

constexpr int NSLOT=3, SLOTB=8192;
constexpr int LDS_K=0, LDS_V=NSLOT*SLOTB, LDS_WS=2*NSLOT*SLOTB, LDS_OST=LDS_WS+NW*64*4, LDS_CUM=LDS_OST+NW*4096, LDS_BYTES=LDS_CUM+SEQ*4;
constexpr float C2=0.125f*1.4426950408889634f;
__device__ __forceinline__ void glds16(const void*gsrc,unsigned lds_dst){unsigned keep;
  asm volatile("s_mov_b32 %0, m0\n\ts_mov_b32 m0, %2\n\ts_nop 0\n\tglobal_load_lds_dwordx4 %1, off\n\ts_mov_b32 m0, %0":"=&s"(keep):"v"(gsrc),"s"(lds_dst):"memory");}
__device__ __forceinline__ float max3f(float a,float b,float c){float r;asm("v_max3_f32 %0, %1, %2, %3":"=v"(r):"v"(a),"v"(b),"v"(c));return r;}
__device__ __forceinline__ float max2f(float a,float b){float r;asm("v_max_f32_e32 %0, %1, %2":"=v"(r):"v"(a),"v"(b));return r;}
__device__ __forceinline__ float fadd_s(float a,float b){float r;asm("v_add_f32_e32 %0, %1, %2":"=v"(r):"v"(a),"v"(b));return r;}
__device__ __forceinline__ float fsub_s(float a,float b){float r;asm("v_sub_f32_e32 %0, %1, %2":"=v"(r):"v"(a),"v"(b));return r;}
typedef float f32x2_t __attribute__((ext_vector_type(2))); typedef __bf16 bf16x2_t __attribute__((ext_vector_type(2)));
__device__ __forceinline__ unsigned cvtpk_s(float lo,float hi){f32x2_t v={lo,hi};bf16x2_t b=__builtin_convertvector(v,bf16x2_t);return __builtin_bit_cast(unsigned,b);}
#define WAIT_BAR(N) asm volatile("s_waitcnt vmcnt(" #N ") lgkmcnt(0)\n\ts_barrier":::"memory")

__device__ __forceinline__ void qkt(f32x16&p0,f32x16&p1,const char*Kslot,const bf16x8*qr,int r32,int hi){
  const char*kb=Kslot+hi*1024+r32*16;
  #pragma unroll
  for(int d0=0;d0<4;++d0){
    const bf16x8 b0=*reinterpret_cast<const bf16x8*>(kb+d0*2048);
    const bf16x8 b1=*reinterpret_cast<const bf16x8*>(kb+d0*2048+512);
    p0=__builtin_amdgcn_mfma_f32_32x32x16_bf16(b0,qr[d0],p0,0,0,0);p1=__builtin_amdgcn_mfma_f32_32x32x16_bf16(b1,qr[d0],p1,0,0,0);}
}
typedef __attribute__((address_space(3))) const char* lds_cptr;
typedef short v4i16_t __attribute__((ext_vector_type(4)));
__device__ __forceinline__ void kload8(bf16x8*kf,lds_cptr kp){
  kf[0]=*(const __attribute__((address_space(3))) bf16x8*)(kp);      kf[1]=*(const __attribute__((address_space(3))) bf16x8*)(kp+512);
  kf[2]=*(const __attribute__((address_space(3))) bf16x8*)(kp+2048); kf[3]=*(const __attribute__((address_space(3))) bf16x8*)(kp+2560);
  kf[4]=*(const __attribute__((address_space(3))) bf16x8*)(kp+4096); kf[5]=*(const __attribute__((address_space(3))) bf16x8*)(kp+4608);
  kf[6]=*(const __attribute__((address_space(3))) bf16x8*)(kp+6144); kf[7]=*(const __attribute__((address_space(3))) bf16x8*)(kp+6656);
}
__device__ __forceinline__ void kload2(bf16x8*kf,lds_cptr kp,int j){ kf[2*j]=*(const __attribute__((address_space(3))) bf16x8*)(kp+j*2048); kf[2*j+1]=*(const __attribute__((address_space(3))) bf16x8*)(kp+j*2048+512); }
__device__ __forceinline__ s16x4 vtr(lds_cptr p){ return __builtin_bit_cast(s16x4,__builtin_amdgcn_ds_read_tr16_b64_v4i16((__attribute__((address_space(3))) v4i16_t*)p)); }
__device__ __forceinline__ float rowmax(const f32x16&p0,const f32x16&p1){
  float a=max3f(p0[0],p0[1],p1[0]),b=max3f(p0[2],p0[3],p1[1]);a=max3f(a,p1[2],p1[3]);
  #pragma unroll
  for(int r=4;r<16;r+=4){a=max3f(a,p0[r],p0[r+1]);b=max3f(b,p0[r+2],p0[r+3]);a=max3f(a,p1[r],p1[r+1]);b=max3f(b,p1[r+2],p1[r+3]);}
  const float m=max2f(a,b);
  auto rr=__builtin_amdgcn_permlane32_swap(__float_as_uint(m),__float_as_uint(m),false,false);
  return max2f(__uint_as_float(rr[0]),__uint_as_float(rr[1]));
}
__device__ __forceinline__ void pv(f32x16*o,int vb,bf16x8 pa0,bf16x8 pa1,bf16x8 pa2,bf16x8 pa3){
  #pragma unroll
  for(int d0=0;d0<2;++d0){s16x4 lo[4],hi[4];
    #pragma unroll
    for(int ks=0;ks<4;++ks){
      asm volatile("ds_read_b64_tr_b16 %0,%1 offset:%c2":"=&v"(lo[ks]):"v"(vb),"i"(d0*4096+ks*1024):"memory");
      asm volatile("ds_read_b64_tr_b16 %0,%1 offset:%c2":"=&v"(hi[ks]):"v"(vb),"i"(d0*4096+ks*1024+512):"memory");}
    asm volatile("s_waitcnt lgkmcnt(0)":::"memory");SBAR();
    #define PK(k) (bf16x8){lo[k][0],lo[k][1],lo[k][2],lo[k][3],hi[k][0],hi[k][1],hi[k][2],hi[k][3]}
    o[d0]=__builtin_amdgcn_mfma_f32_32x32x16_bf16(pa0,PK(0),o[d0],0,0,0);
    o[d0]=__builtin_amdgcn_mfma_f32_32x32x16_bf16(pa1,PK(1),o[d0],0,0,0);
    o[d0]=__builtin_amdgcn_mfma_f32_32x32x16_bf16(pa2,PK(2),o[d0],0,0,0);
    o[d0]=__builtin_amdgcn_mfma_f32_32x32x16_bf16(pa3,PK(3),o[d0],0,0,0);
    #undef PK
  }
}

#ifndef ATTN_STORE16
#define ATTN_STORE16(p,v) (*(u32x4*)(p)=(v))
#endif
template<int THRL> __device__ __forceinline__ void attn_unit(int b,int h,int qb,const bf16*Q,const bf16*__restrict__ K,const bf16*__restrict__ V,bf16*O,const float*__restrict__ cumG,char*shm){
  const int tid=threadIdx.x,lane=tid&63,r32=lane&31,hi=lane>>5; const int wid=__builtin_amdgcn_readfirstlane(tid>>6);
  const long rowbase=(long)b*SEQ; const int q0=qb*QB;
  const bf16*Qw=Q+(rowbase+q0+wid*QBLK)*PQ+h*D;
  const bf16*Kh=K+rowbase*PQ+h*D,*Vh=V+rowbase*PQ+h*D;
  const unsigned lds0=(unsigned)(uintptr_t)shm;
  float*wsf=(float*)(shm+LDS_WS)+wid*64;
  const bf16*ksrc=Kh+(long)lane*PQ+wid*8;
  const bf16*vsrc=Vh+(long)(16*(wid&3)+(lane>>2))*PQ+(wid>>2)*32+(lane&3)*8;
  const unsigned kdst=lds0+LDS_K+wid*1024, vdst=lds0+LDS_V+wid*1024;
  #define DMA_K(t,slot) glds16(ksrc+(long)(t)*KVBLK*PQ,(unsigned)__builtin_amdgcn_readfirstlane(kdst+(slot)))
  #define DMA_V(t,slot) glds16(vsrc+(long)(t)*KVBLK*PQ,(unsigned)__builtin_amdgcn_readfirstlane(vdst+(slot)))
  const int vb0=(int)(lds0+LDS_V)+((lane>>4)&1)*32+(lane&3)*8+(4*hi+((lane&15)>>2))*64;
  const char*Kbase=shm+LDS_K; bf16x8 kf[8];
  const lds_cptr shm3=(lds_cptr)shm; const lds_cptr kp0=shm3+LDS_K+hi*1024+r32*16; const lds_cptr vp0=shm3+LDS_V+((lane>>4)&1)*32+(lane&3)*8+(4*hi+((lane&15)>>2))*64;
  const int NT=(q0+QB)/KVBLK;
  typedef __attribute__((address_space(3))) float lds_f32; typedef __attribute__((address_space(3))) const f32x4v lds_cf4;
  { lds_f32*cl=(lds_f32*)(shm3+LDS_CUM)+tid; const float*cg_=cumG+tid; float cv_[8];
    _Pragma("unroll") for(int i=0;i<8;++i)cv_[i]=cg_[i*NW*64];
    _Pragma("unroll") for(int i=0;i<8;++i)cl[i*NW*64]=cv_[i]; }
  const lds_cptr cum3=shm3+LDS_CUM+16*hi;
  DMA_K(0,0);DMA_V(0,0);DMA_K(1,SLOTB);
  bf16x8 qr[4];
  #pragma unroll
  for(int d0=0;d0<4;++d0)qr[d0]=*reinterpret_cast<const bf16x8*>(&Qw[(long)r32*PQ+d0*16+hi*8]);
  float mhat=0.f,l_reg=0.f,qm=0.f;f32x16 o[2];o[0]=f32x16{};o[1]=f32x16{};
  const int qrel=wid*QBLK+r32;
  #define CMASK(P0,P1,t) do{int jb_=(t)-(NT-4); if(jb_>=0)cmask(P0,P1,jb_,qrel,hi);}while(0)
  bool resc=false;
  #define START(P0,P1) do{ const float rm=rowmax(P0,P1); resc=false; \
    if(__any(rm>(float)THRL)){ const float dl=__builtin_fmaxf(rm,0.f); mhat+=dl; qm-=dl; \
      _Pragma("unroll") for(int r=0;r<16;++r){P0[r]-=dl;P1[r]-=dl;} } \
    _Pragma("unroll") for(int r=0;r<16;++r)P0[r]=__builtin_amdgcn_exp2f(P0[r]); }while(0)
  #define BIAS(P0,P1,t) do{ const lds_cptr cb_=cum3+(t)*256; \
    _Pragma("unroll") for(int g_=0;g_<4;++g_){ const f32x4v c0_=*(lds_cf4*)(cb_+g_*32), c1_=*(lds_cf4*)(cb_+128+g_*32); \
      _Pragma("unroll") for(int i_=0;i_<4;++i_){ P0[4*g_+i_]=qm-c0_[i_]; P1[4*g_+i_]=qm-c1_[i_]; } } }while(0)
  #define RESC() do{ if(resc){ asm volatile("s_waitcnt lgkmcnt(0)":::"memory"); \
      _Pragma("unroll") for(int d_=0;d_<2;++d_) _Pragma("unroll") for(int r=0;r<16;++r)o[d_][r]*=wsf[crow(r,hi)]; } }while(0)
  f32x16 pA0,pA1,pB0,pB1;
  int sl_prev=0,sl_cur=0,sl_next=SLOTB;
  #define ROT() do{sl_prev=sl_cur;sl_cur=sl_next;sl_next=(sl_next==(NSLOT-1)*SLOTB)?0:sl_next+SLOTB;}while(0)
  DMA_K(2,2*SLOTB);
  WAIT_BAR(3);
  qm=*(const __attribute__((address_space(3))) float*)(shm3+LDS_CUM+(q0+qrel)*4);
  BIAS(pA0,pA1,0);
  qkt(pA0,pA1,Kbase,qr,r32,hi);asm volatile("s_nop 15\n\ts_nop 7":"+v"(pA0),"+v"(pA1));CMASK(pA0,pA1,0);
  START(pA0,pA1);
  _Pragma("unroll") for(int r=0;r<16;++r)pA1[r]=__builtin_amdgcn_exp2f(pA1[r]);
  WAIT_BAR(0);
  DMA_K(3,0);DMA_V(1,SLOTB);
  ROT();
  kload8(kf,kp0+sl_cur);
  BIAS(pB0,pB1,1);
  WAIT_BAR(2);
  s16x4 vlo[8],vhi[8]; u32x4 pw0,pw1,pw2,pw3;
  #define PKW(P,B) cvtpk_s(P[B],P[B+1])
  #define PAF(k) __builtin_bit_cast(bf16x8,pw##k)
  #define VFR(i) (bf16x8){vlo[i][0],vlo[i][1],vlo[i][2],vlo[i][3],vhi[i][0],vhi[i][1],vhi[i][2],vhi[i][3]}
  #define PIN(x) asm volatile("":"+v"(x))
  #define MX3(a,b,c) __builtin_fmaxf(__builtin_fmaxf((a),(b)),(c))
  #define GAPA(MF,A0,A1,A2,A3,W0,W1,PW) do{ MF; sacc+=A0; sacc+=A1; sacc+=A2; sacc+=A3; PIN(sacc); W0; W1; PIN(PW); SBAR(); }while(0)
  #define EX(v) __builtin_amdgcn_exp2f(v)
  #define GAPB(MF,X,B,EXTRA) do{ MF; X[B]=EX(X[B]); X[B+1]=EX(X[B+1]); X[B+2]=EX(X[B+2]); X[B+3]=EX(X[B+3]); PIN(X); EXTRA; SBAR(); }while(0)
  #define BRD(g) (*(lds_cf4*)(cbn_+((g)&3)*32+((g)>>2)*128))
  #define BCP(X,B,c) do{ X[B]=qm-c[0]; X[B+1]=qm-c[1]; X[B+2]=qm-c[2]; X[B+3]=qm-c[3]; PIN(X); }while(0)
  #define VRD(i) do{ vlo[i]=vtr(vp_+(((i)>>2)*4096+((i)&3)*1024)); vhi[i]=vtr(vp_+(((i)>>2)*4096+((i)&3)*1024+512)); }while(0)
  #define KRD(G,j) do{ if(G){ kload2(kf,kp0+sl_next,j); SBAR(); } }while(0)
  #define STEP(C0,C1,P0,P1,t,GK,GV,GL) do{ SBAR(); \
    const lds_cptr vp_=vp0+sl_prev; \
    VRD(0); SBAR(); float sacc=(P0[0]+P0[1]); \
    GAPA(C0=__builtin_amdgcn_mfma_f32_32x32x16_bf16(kf[0],qr[0],C0,0,0,0), P0[2],P0[3],P0[4],P0[5],     pw0[0]=PKW(P0,0), pw0[1]=PKW(P0,2), pw0); \
    VRD(4); SBAR(); GAPA(C1=__builtin_amdgcn_mfma_f32_32x32x16_bf16(kf[1],qr[0],C1,0,0,0), P0[6],P0[7],P0[8],P0[9],     pw0[2]=PKW(P0,4), pw0[3]=PKW(P0,6), pw0); \
    VRD(1); SBAR(); GAPA(C0=__builtin_amdgcn_mfma_f32_32x32x16_bf16(kf[2],qr[1],C0,0,0,0),   P0[10],P0[11],P0[12],P0[13], pw1[0]=PKW(P0,8), pw1[1]=PKW(P0,10), pw1); \
    VRD(5); SBAR(); GAPA(C1=__builtin_amdgcn_mfma_f32_32x32x16_bf16(kf[3],qr[1],C1,0,0,0),   P0[14],P0[15],P1[0],P1[1],   pw1[2]=PKW(P0,12),pw1[3]=PKW(P0,14), pw1); \
    VRD(2); SBAR(); GAPA(C0=__builtin_amdgcn_mfma_f32_32x32x16_bf16(kf[4],qr[2],C0,0,0,0),   P1[2],P1[3],P1[4],P1[5],     pw2[0]=PKW(P1,0), pw2[1]=PKW(P1,2), pw2); \
    VRD(6); SBAR(); GAPA(C1=__builtin_amdgcn_mfma_f32_32x32x16_bf16(kf[5],qr[2],C1,0,0,0),   P1[6],P1[7],P1[8],P1[9],     pw2[2]=PKW(P1,4), pw2[3]=PKW(P1,6), pw2); \
    VRD(3); SBAR(); GAPA(C0=__builtin_amdgcn_mfma_f32_32x32x16_bf16(kf[6],qr[3],C0,0,0,0),   P1[10],P1[11],P1[12],P1[13], pw3[0]=PKW(P1,8), pw3[1]=PKW(P1,10), pw3); \
    VRD(7); SBAR(); GAPA(C1=__builtin_amdgcn_mfma_f32_32x32x16_bf16(kf[7],qr[3],C1,0,0,0),   P1[14],P1[15],0.f,0.f,       pw3[2]=PKW(P1,12),pw3[3]=PKW(P1,14), pw3); \
    l_reg+=sacc; \
    if(GK){DMA_K((t)+3,sl_cur);} if(GV){DMA_V((t)+1,sl_next);} \
    CMASK(C0,C1,t); \
    { float a=MX3(C0[0],C0[1],C1[0]),b=MX3(C0[2],C0[3],C1[1]); a=MX3(a,C1[2],C1[3]); \
      _Pragma("unroll") for(int r=4;r<16;r+=4){a=MX3(a,C0[r],C0[r+1]);b=MX3(b,C0[r+2],C0[r+3]);a=MX3(a,C1[r],C1[r+1]);b=MX3(b,C1[r+2],C1[r+3]);} \
      float rm=__builtin_fmaxf(a,b); { auto rr=__builtin_amdgcn_permlane32_swap(__float_as_uint(rm),__float_as_uint(rm),false,false); rm=__builtin_fmaxf(__uint_as_float(rr[0]),__uint_as_float(rr[1])); } \
      resc=false; \
      if(__builtin_expect(__any(rm>(float)THRL),0)){ const float dl=__builtin_fmaxf(rm,0.f); mhat+=dl; \
        _Pragma("unroll") for(int r=0;r<16;++r){C0[r]-=dl;C1[r]-=dl;} \
        qm-=dl; \
        const float f=__builtin_amdgcn_exp2f(-dl); l_reg*=f; if(hi==0)wsf[r32]=f; resc=true; } } \
    const lds_cptr cbn_=cum3+((t)+1)*256; f32x4v ca_; if(GL){ca_=BRD(0);} \
    SBAR(); \
    GAPB(o[0]=__builtin_amdgcn_mfma_f32_32x32x16_bf16(PAF(0),VFR(0),o[0],0,0,0), C0,0, if(GL){BCP(P0,0,ca_);ca_=BRD(1);}); \
    GAPB(o[1]=__builtin_amdgcn_mfma_f32_32x32x16_bf16(PAF(0),VFR(4),o[1],0,0,0), C0,4, if(GL){BCP(P0,4,ca_);ca_=BRD(2);}); \
    KRD(GL,0); GAPB(o[0]=__builtin_amdgcn_mfma_f32_32x32x16_bf16(PAF(1),VFR(1),o[0],0,0,0), C0,8, if(GL){BCP(P0,8,ca_);ca_=BRD(3);}); \
    KRD(GL,1); GAPB(o[1]=__builtin_amdgcn_mfma_f32_32x32x16_bf16(PAF(1),VFR(5),o[1],0,0,0), C0,12, if(GL){BCP(P0,12,ca_);ca_=BRD(4);}); \
    KRD(GL,2); GAPB(o[0]=__builtin_amdgcn_mfma_f32_32x32x16_bf16(PAF(2),VFR(2),o[0],0,0,0), C1,0, if(GL){BCP(P1,0,ca_);ca_=BRD(5);}); \
    KRD(GL,3); GAPB(o[1]=__builtin_amdgcn_mfma_f32_32x32x16_bf16(PAF(2),VFR(6),o[1],0,0,0), C1,4, if(GL){BCP(P1,4,ca_);ca_=BRD(6);}); \
    GAPB(o[0]=__builtin_amdgcn_mfma_f32_32x32x16_bf16(PAF(3),VFR(3),o[0],0,0,0), C1,8, if(GL){BCP(P1,8,ca_);ca_=BRD(7);}); \
    GAPB(o[1]=__builtin_amdgcn_mfma_f32_32x32x16_bf16(PAF(3),VFR(7),o[1],0,0,0), C1,12, if(GL){BCP(P1,12,ca_);}); \
    }while(0)
  int t=1;
  #undef CMASK
  #define CMASK(P0,P1,t) do{}while(0)
  for(;t+5<NT;t+=2){
    STEP(pB0,pB1,pA0,pA1,t,true,true,true);     WAIT_BAR(2); RESC(); ROT();
    STEP(pA0,pA1,pB0,pB1,t+1,true,true,true);   WAIT_BAR(2); RESC(); ROT();
  }
  #undef CMASK
  #define CMASK(P0,P1,t) do{int jb_=(t)-(NT-4); if(jb_>=0)cmask(P0,P1,jb_,qrel,hi);}while(0)
  #define ENDW(tt) do{ if((tt)+3<NT){WAIT_BAR(2);} else if((tt)+2<NT){WAIT_BAR(1);} else {WAIT_BAR(0);} }while(0)
  for(;t+1<NT;t+=2){
    STEP(pB0,pB1,pA0,pA1,t,(t+3<NT),(t+1<NT),(t+1<NT));       ENDW(t);   RESC(); ROT();
    STEP(pA0,pA1,pB0,pB1,t+1,(t+4<NT),(t+2<NT),(t+2<NT));     ENDW(t+1); RESC(); ROT();
  }
  STEP(pB0,pB1,pA0,pA1,NT-1,false,false,false); RESC();
  { float sacc=pB0[0]+pB0[1]; _Pragma("unroll") for(int r=2;r<16;++r)sacc+=pB0[r]; _Pragma("unroll") for(int r=0;r<16;++r)sacc+=pB1[r]; l_reg+=sacc;
    pw0=(u32x4){PKW(pB0,0),PKW(pB0,2),PKW(pB0,4),PKW(pB0,6)};pw1=(u32x4){PKW(pB0,8),PKW(pB0,10),PKW(pB0,12),PKW(pB0,14)};pw2=(u32x4){PKW(pB1,0),PKW(pB1,2),PKW(pB1,4),PKW(pB1,6)};pw3=(u32x4){PKW(pB1,8),PKW(pB1,10),PKW(pB1,12),PKW(pB1,14)};
    SBAR(); pv(o,vb0+sl_cur,PAF(0),PAF(1),PAF(2),PAF(3)); }
  #undef PKW
  #undef PAF
  #undef VFR
  #undef PIN
  #undef MX3
  #undef GAPA
  #undef GAPB
  #undef BRD
  #undef BCP
  #undef BIAS
  #undef EX
  #undef VRD
  #undef KRD
  #undef STEP
  #undef ENDW
  {auto rr=__builtin_amdgcn_permlane32_swap(__float_as_uint(l_reg),__float_as_uint(l_reg),false,false);l_reg=__uint_as_float(rr[0])+__uint_as_float(rr[1]);}
  if(hi==0)wsf[32+r32]=l_reg;asm volatile("s_waitcnt lgkmcnt(0)":::"memory");
  float rli[16];
  #pragma unroll
  for(int r=0;r<16;++r)rli[r]=__builtin_amdgcn_rcpf(wsf[32+crow(r,hi)]);
  bf16*Ow=O+(rowbase+q0+wid*QBLK)*PO+h*D;
  { bf16*stg=(bf16*)(shm+LDS_OST)+wid*2048;
    #pragma unroll
    for(int r=0;r<16;++r){const int orow=crow(r,hi);
      #pragma unroll
      for(int d0=0;d0<2;++d0)stg[orow*64+d0*32+r32]=__float2bfloat16(o[d0][r]*rli[r]);}
    asm volatile("s_waitcnt lgkmcnt(0)":::"memory");
    #pragma unroll
    for(int i=0;i<4;++i){const int row=i*8+(lane>>3),ch=lane&7; const u32x4 v=*(const u32x4*)(stg+row*64+ch*8); ATTN_STORE16(Ow+(long)row*PO+ch*8,v);} }
  asm volatile("s_waitcnt lgkmcnt(0)\n\ts_barrier":::"memory");
  #undef DMA_K
  #undef DMA_V
  #undef CMASK
  #undef START
  #undef RESC
  #undef ROT
}
constexpr int ATTN_LDS_BYTES=LDS_BYTES;
struct AttnTensors { const bf16* Q; const bf16* K; const bf16* V; bf16* O; const float* cum; };
struct AttnUnit { int bh; int qb; };
struct StaticOrder {
  int vcu,G;
  __device__ __forceinline__ explicit StaticOrder(int grid,int block):vcu((grid%8==0)?((block%8)*(grid/8)+block/8):block),G(grid){}
  __device__ __forceinline__ bool next(int i,AttnUnit&u)const{
    if(G==256){ if(i>=2)return false; const int s=vcu&7; u.bh=vcu>>3; u.qb=(i==0)?s:15-s; return true; }
    const int L=i*G+vcu; if(L>=BATCH*NHEAD*NQB)return false; u.bh=L/NQB; u.qb=L%NQB; return true; }
};
template<class Sched,int THRL=8> __device__ __forceinline__ void attn_phase(char*lds,const AttnTensors&T,const Sched&S){
  AttnUnit u;
  for(int i=0;S.next(i,u);++i){ attn_unit<THRL>(u.bh/NHEAD,u.bh%NHEAD,u.qb,T.Q,T.K,T.V,T.O,T.cum+(long)u.bh*SEQ,lds); }
}
#undef SBAR
#undef WAIT_BAR
}
constexpr int NWAVES = 8, NTHR = 512;
constexpr int BATCH = 4, SEQ = 4096, DMODEL = 1024, MTOK = BATCH * SEQ;
constexpr int NQKV = 3072, INCOLS = 3096, DFF = 2816, NEXP = 8;
constexpr float EPS = 1e-6f, LOG2E = 1.4426950408889634f;
constexpr size_t MiB = 1u << 20;
constexpr size_t WS_CTL = 0, CTL_ZERO_BYTES = 1 * MiB;
constexpr size_t WS_MOD = 1 * MiB;
constexpr size_t WS_WSK = WS_MOD + 256 * 1024;
constexpr size_t WS_AL = WS_WSK + 128 * 1024;
constexpr size_t WS_ROUTE = 2 * MiB;
constexpr size_t WS_ROWTOK = 3 * MiB;
constexpr size_t WS_CUM = 4 * MiB;
constexpr size_t WS_FFGLR = 5 * MiB;
constexpr size_t WS_GLAEB = 7 * MiB;
constexpr size_t WS_WIN0 = 8 * MiB, WS_WO0 = 14 * MiB, WS_WGU0 = 16 * MiB, WS_WD0 = 27 * MiB;
constexpr size_t WS_WIN1 = 33 * MiB, WS_WGLU = 35 * MiB, WS_WO1 = 37 * MiB, WS_S5T = 39 * MiB, WS_S5WA = 79 * MiB;
constexpr size_t WS_H3 = 8 * MiB;
constexpr size_t WS_WEGU = 95 * MiB, WS_WED = 183 * MiB;
constexpr size_t WS_YPERM = 95 * MiB;
constexpr size_t WS_BIG = 227 * MiB;
constexpr size_t WS_QKV = WS_BIG, WS_MIX = WS_BIG + 96 * MiB, WS_H = WS_BIG + 128 * MiB;
constexpr size_t WS_ACT = WS_BIG;
constexpr size_t WS_AU = WS_BIG, WS_E = WS_BIG + 40 * MiB, WS_YG = WS_BIG + 56 * MiB, WS_Z = WS_BIG + 88 * MiB;
constexpr size_t WS_ACTP = WS_BIG;
constexpr size_t WS_END = 414 * MiB;
constexpr int MAXPROWS = 34816;
constexpr int CW_TMO = 0, CW_CODE = 1, CW_BAR = 4096, CW_ECNT = 8192;
constexpr int RING_BYTES = 131072, GTAB_OFF = RING_BYTES, GTAB_BYTES = 16384, MISC_OFF = GTAB_OFF + GTAB_BYTES, LDS_BYTES = MISC_OFF + 1024;

typedef GAS unsigned gu32;
#define RLX_AGENT __ATOMIC_RELAXED, __HIP_MEMORY_SCOPE_AGENT
#define LDS_WAIT() asm volatile("s_waitcnt lgkmcnt(0)" ::: "memory")
#define VM_WAIT() asm volatile("s_waitcnt vmcnt(0)" ::: "memory")

#define XB_TMO      128
#define XB_XCNT(j)  (256  + 64 * (j))
#define XB_XSUB(j)  (1280 + 64 * (j))
#define XB_XGEN(j)  (2304 + 64 * (j))
#define XB_TOP      3328
#define XB_TOPGEN   3392
#define XCD_BAR_WORDS 3456
#define XB_SPIN_CAP (1u << 18)
__device__ __forceinline__ unsigned xb_ld(unsigned* p)              { return __hip_atomic_load(p, __ATOMIC_RELAXED, __HIP_MEMORY_SCOPE_AGENT); }
__device__ __forceinline__ unsigned xb_add(unsigned* p, unsigned v) { return __hip_atomic_fetch_add(p, v, __ATOMIC_RELAXED, __HIP_MEMORY_SCOPE_AGENT); }
__device__ __forceinline__ unsigned xb_xcc_id() { return (unsigned)__builtin_amdgcn_s_getreg((3 << 11) | 20) & 0xFu; }
#define XB_SPIN(cond, bar) do { unsigned _sp = 0; while (cond) { __builtin_amdgcn_s_sleep(1); \
    if ((++_sp & 255u) == 0u) { if (xb_ld(&(bar)[XB_TMO])) break; if (_sp > XB_SPIN_CAP) { atomicAdd(&(bar)[XB_TMO], 1u); break; } } } } while (0)
struct XcdBarrier { unsigned* bar; unsigned x; volatile LAS unsigned* st; };
__device__ __forceinline__ XcdBarrier xcd_barrier_post(unsigned* bar, volatile LAS unsigned* st) {
    XcdBarrier b; b.bar = bar; b.x = xb_xcc_id(); b.st = st;
    if (threadIdx.x == 0) (void)xb_add(&bar[XB_XCNT(b.x)], 1u);
    return b;
}
__device__ __forceinline__ void xcd_barrier_complete(unsigned* bar, unsigned x, unsigned& nloc, unsigned& nx) {
    const unsigned G = gridDim.x * gridDim.y * gridDim.z;
    unsigned sum, cnt, mine, sp = 0u;
    for (;;) {
        sum = 0u; cnt = 0u; mine = 0u;
#pragma unroll
        for (unsigned j = 0; j < 16; ++j) { const unsigned c = xb_ld(&bar[XB_XCNT(j)]); sum += c; cnt += (c > 0u) ? 1u : 0u; mine = (j == x) ? c : mine; }
        if (sum == G) break;
        __builtin_amdgcn_s_sleep(1);
        if ((++sp & 255u) == 0u) { if (xb_ld(&bar[XB_TMO])) break; if (sp > XB_SPIN_CAP) { atomicAdd(&bar[XB_TMO], 1u); break; } }
    }
    nloc = mine > 0u ? mine : 1u; nx = cnt > 0u ? cnt : 1u;
}
__device__ __forceinline__ void xcd_barrier(const XcdBarrier& b) {
    asm volatile("s_waitcnt vmcnt(0)" ::: "memory");
    __syncthreads();
    if (threadIdx.x == 0) {
        unsigned* bar = b.bar;
        __builtin_amdgcn_s_waitcnt(0);
        unsigned nloc = b.st[0], nx = b.st[1];
        if (nloc == 0u) { xcd_barrier_complete(bar, b.x, nloc, nx); b.st[0] = nloc; b.st[1] = nx; }
        const unsigned old = xb_add(&bar[XB_XSUB(b.x)], 1u);
        const unsigned gen = old / nloc;
        if (old + 1u == (gen + 1u) * nloc) {
            __builtin_amdgcn_fence(__ATOMIC_RELEASE, "agent");
            asm volatile("s_waitcnt vmcnt(0)" ::: "memory");
            const unsigned og = xb_add(&bar[XB_TOP], 1u);
            const unsigned tg = og / nx;
            if (og + 1u == (tg + 1u) * nx) xb_add(&bar[XB_TOPGEN], 1u);
            else XB_SPIN(xb_ld(&bar[XB_TOPGEN]) == tg, bar);
            __builtin_amdgcn_fence(__ATOMIC_ACQUIRE, "agent");
            xb_add(&bar[XB_XGEN(b.x)], 1u);
            asm volatile("s_waitcnt vmcnt(0)" ::: "memory");
        } else {
            XB_SPIN(xb_ld(&bar[XB_XGEN(b.x)]) == gen, bar);
            __builtin_amdgcn_fence(__ATOMIC_ACQUIRE, "agent");
            asm volatile("s_waitcnt vmcnt(0)" ::: "memory");
        }
    }
    __syncthreads();
}

struct Frame {
    LAS unsigned char* lds;
    gu32* ctl;
    int tid, lane, wave, vcu, G;
    const float* const* in; float* out; unsigned char* ws;
};
__device__ __forceinline__ float wave_sum(float v) {
#pragma unroll
    for (int o = 1; o < 64; o <<= 1) v += __shfl_xor(v, o);
    return v;
}
__device__ __forceinline__ unsigned f2bf(float f) { unsigned u = __builtin_bit_cast(unsigned, f); return (u + 0x7fffu + ((u >> 16) & 1u)) >> 16; }
__device__ __forceinline__ unsigned pk2(float lo, float hi) { return f2bf(lo) | (f2bf(hi) << 16); }
__device__ __forceinline__ float log_sigmoid_f(float x) { return fminf(x, 0.f) - log1pf(expf(-fabsf(x))); }
__device__ __forceinline__ void tr_item(const float* __restrict__ W, int ldw, int col0, bf16_t* __restrict__ WT, int K, int drow, int k0, LAS float* scr, int lane) {
#pragma unroll 8
    for (int i = 0; i < 32; ++i) { const int kk = 2 * i + (lane >> 5); scr[kk * 33 + (lane & 31)] = W[(size_t)(k0 + kk) * ldw + col0 + (lane & 31)]; }
    LDS_WAIT(); asm volatile("" ::: "memory");
    const int c = lane & 7;
#pragma unroll
    for (int j = 0; j < 4; ++j) { const int n = (lane >> 3) + 8 * j; const LAS float* s = scr + (8 * c) * 33 + n;
        u32x4 o; o.x = pk2(s[0 * 33], s[1 * 33]); o.y = pk2(s[2 * 33], s[3 * 33]); o.z = pk2(s[4 * 33], s[5 * 33]); o.w = pk2(s[6 * 33], s[7 * 33]);
        *(GAS u32x4*)(WT + (size_t)(drow + n) * K + k0 + 8 * c) = o; }
    LDS_WAIT(); asm volatile("" ::: "memory");
}
__device__ __forceinline__ void tr_seg(const float* W, int ldw, int col0, int ncols, int K, bf16_t* WT, int mode, int rowoff, int item, LAS float* scr, int lane) {
    const int nblk = ncols >> 5, kb = item / nblk, nb = item - kb * nblk, n0 = nb * 32;
    const int drow = mode ? (((n0 >> 7) << 8) + (n0 & 127) + rowoff) : (rowoff + n0);
    tr_item(W, ldw, col0 + n0, WT, K, drow, kb * 64, scr, lane);
}
constexpr int TR_I_WIN = 768, TR_I_SQ = 512, TR_I_FF = 1408;
constexpr int TR_NITEMS = 2 * TR_I_WIN + TR_I_SQ + 3 * TR_I_FF + 3 * TR_I_SQ + 24 * TR_I_FF;
__device__ __forceinline__ void p0_transposes(Frame& F) {
    LAS float* scr = (LAS float*)(F.lds + F.wave * 16384);
    unsigned char* ws = F.ws;
    const int gw = F.vcu * NWAVES + F.wave, NGW = F.G * NWAVES;
    for (int it = gw; it < TR_NITEMS; it += NGW) {
        int r = it;
        if (r < TR_I_WIN) { tr_seg(F.in[5], INCOLS, 0, 1536, 1024, (bf16_t*)(ws + WS_WIN0), 0, 0, r, scr, F.lane); continue; } r -= TR_I_WIN;
        if (r < TR_I_WIN) { tr_seg(F.in[5], INCOLS, 1544, 1536, 1024, (bf16_t*)(ws + WS_WIN0), 0, 1536, r, scr, F.lane); continue; } r -= TR_I_WIN;
        if (r < TR_I_SQ) { tr_seg(F.in[10], 1024, 0, 1024, 1024, (bf16_t*)(ws + WS_WO0), 0, 0, r, scr, F.lane); continue; } r -= TR_I_SQ;
        if (r < TR_I_FF) { tr_seg(F.in[14], DFF, 0, DFF, 1024, (bf16_t*)(ws + WS_WGU0), 1, 0, r, scr, F.lane); continue; } r -= TR_I_FF;
        if (r < TR_I_FF) { tr_seg(F.in[15], DFF, 0, DFF, 1024, (bf16_t*)(ws + WS_WGU0), 1, 128, r, scr, F.lane); continue; } r -= TR_I_FF;
        if (r < TR_I_FF) { tr_seg(F.in[16], 1024, 0, 1024, DFF, (bf16_t*)(ws + WS_WD0), 0, 0, r, scr, F.lane); continue; } r -= TR_I_FF;
        if (r < TR_I_SQ) { tr_seg(F.in[20], 1024, 0, 1024, 1024, (bf16_t*)(ws + WS_WIN1), 0, 0, r, scr, F.lane); continue; } r -= TR_I_SQ;
        if (r < TR_I_SQ) { tr_seg(F.in[29], 1024, 0, 1024, 1024, (bf16_t*)(ws + WS_WGLU), 0, 0, r, scr, F.lane); continue; } r -= TR_I_SQ;
        if (r < TR_I_SQ) { tr_seg(F.in[30], 1024, 0, 1024, 1024, (bf16_t*)(ws + WS_WO1), 0, 0, r, scr, F.lane); continue; } r -= TR_I_SQ;
        const int idx = r / TR_I_FF, ri = r - idx * TR_I_FF, e = idx / 3, kind = idx - e * 3;
        if (kind == 0) tr_seg(F.in[35] + (size_t)e * 1024 * DFF, DFF, 0, DFF, 1024, (bf16_t*)(ws + WS_WEGU) + (size_t)e * 5632 * 1024, 1, 0, ri, scr, F.lane);
        else if (kind == 1) tr_seg(F.in[36] + (size_t)e * 1024 * DFF, DFF, 0, DFF, 1024, (bf16_t*)(ws + WS_WEGU) + (size_t)e * 5632 * 1024, 1, 128, ri, scr, F.lane);
        else tr_seg(F.in[37] + (size_t)e * DFF * 1024, 1024, 0, 1024, DFF, (bf16_t*)(ws + WS_WED) + (size_t)e * 1024 * DFF, 0, 0, ri, scr, F.lane);
    }
}
__device__ __forceinline__ void sincos_rev(double ang, float& cs, float& sn) {
    const double rev = ang * 0.15915494309189535; const float fr = (float)(rev - __builtin_rint(rev));
    cs = __builtin_amdgcn_cosf(fr); sn = __builtin_amdgcn_sinf(fr);
}
__device__ __forceinline__ void p0_mod_job(Frame& F, int job) {
    const int s = job / 48, cg = job - s * 48;
    const float* W = s == 0 ? F.in[3] : s == 1 ? F.in[12] : s == 2 ? F.in[18] : F.in[32]; const float* bias = s == 0 ? F.in[4] : s == 1 ? F.in[13] : s == 2 ? F.in[19] : F.in[33];
    LAS float* sc = (LAS float*)F.lds;
    LAS float* part = sc + 4096;
    for (int i = F.tid; i < 4096; i += NTHR) { const float v = F.in[1][i]; sc[i] = v / (1.f + expf(-v)); }
    __syncthreads();
    const int col = cg * 64 + F.lane; float a0 = 0.f, a1 = 0.f, a2 = 0.f, a3 = 0.f;
    const float* wp = W + (size_t)(F.wave * 128) * 3072 + col;
#pragma unroll 8
    for (int k = 0; k < 128; ++k) { const float w = wp[(size_t)k * 3072]; const int kk = F.wave * 128 + k;
        a0 += sc[kk] * w; a1 += sc[1024 + kk] * w; a2 += sc[2048 + kk] * w; a3 += sc[3072 + kk] * w; }
    part[(F.wave * 4 + 0) * 64 + F.lane] = a0; part[(F.wave * 4 + 1) * 64 + F.lane] = a1; part[(F.wave * 4 + 2) * 64 + F.lane] = a2; part[(F.wave * 4 + 3) * 64 + F.lane] = a3;
    __syncthreads();
    if (F.tid < 256) { const int b = F.tid >> 6, l = F.tid & 63; float t = bias[cg * 64 + l];
#pragma unroll
        for (int w = 0; w < 8; ++w) t += part[(w * 4 + b) * 64 + l];
        ((float*)(F.ws + WS_MOD))[(size_t)(s * 4 + b) * 3072 + cg * 64 + l] = t; }
    __syncthreads();
}
__device__ __forceinline__ void p0_s5_job(Frame& F, int job) {
    const int g = job >> 2, qd = job & 3, tid = F.tid;
    LAS float* L = (LAS float*)F.lds;
    LAS float* bbr = L;
    LAS float* bbi = L + 1024;
    LAS float* cr = L + 2048;
    LAS float* ci = L + 3072;
    LAS float* pwr = L + 4096;
    LAS float* pwi = pwr + 64 * 34;
    LAS float* Kt = pwi + 64 * 34;
    const float* lam_re = F.in[21] + g * 64; const float* lam_im = F.in[22] + g * 64; const float dt = expf(F.in[23][g]);
    const float* b_re = F.in[24] + (size_t)g * 1024; const float* b_im = F.in[25] + (size_t)g * 1024;
    const float* c_re = F.in[26] + (size_t)g * 1024; const float* c_im = F.in[27] + (size_t)g * 1024;
    for (int i = tid; i < 1024; i += NTHR) { cr[i] = c_re[i]; ci[i] = c_im[i]; }
    for (int i = tid; i < 64 * 33; i += NTHR) { const int p = i / 33, tau = i - p * 33; const float lr = lam_re[p], li = lam_im[p];
        const float mg = expf((float)tau * lr * dt); float cs, sn; sincos_rev((double)tau * (double)li * (double)dt, cs, sn); pwr[p * 34 + tau] = mg * cs; pwi[p * 34 + tau] = mg * sn; }
    for (int i = tid; i < 1024; i += NTHR) { const int p = i >> 4; const float lr = lam_re[p], li = lam_im[p];
        float cs, sn; sincos_rev((double)li * (double)dt, cs, sn);
        const float mg = expf(lr * dt), ar = mg * cs, ai = mg * sn, den = lr * lr + li * li, nr = ar - 1.f, ni = ai;
        const float fr = (nr * lr + ni * li) / den, fi = (ni * lr - nr * li) / den; const float br = b_re[i], bi = b_im[i];
        bbr[i] = fr * br - fi * bi; bbi[i] = fr * bi + fi * br; }
    __syncthreads();
    {
        const int tau = tid >> 4, k = tid & 15; float acc[16];
#pragma unroll
        for (int j = 0; j < 16; ++j) acc[j] = 0.f;
        for (int p = 0; p < 64; ++p) { const float c_r = cr[k * 64 + p], c_i = ci[k * 64 + p], w_r = pwr[p * 34 + tau], w_i = pwi[p * 34 + tau];
            const float m_r = c_r * w_r - c_i * w_i, m_i = c_r * w_i + c_i * w_r;
#pragma unroll
            for (int j = 0; j < 16; ++j) acc[j] += m_r * bbr[p * 16 + j] - m_i * bbi[p * 16 + j]; }
#pragma unroll
        for (int j = 0; j < 16; ++j) Kt[tau * 256 + k * 16 + j] = acc[j];
    }
    __syncthreads();
    bf16_t* T = (bf16_t*)(F.ws + WS_S5T) + (size_t)g * 512 * 640;
    for (int ch = tid; ch < 128 * 80; ch += NTHR) {
        const int rl = ch / 80, c8 = (ch - rl * 80) * 8, n = qd * 128 + rl, i = n >> 4, k = n & 15; float v[8];
        if (c8 < 512) { const int j = c8 >> 4, k0 = c8 & 15;
#pragma unroll
            for (int q = 0; q < 8; ++q) v[q] = (j <= i) ? Kt[(i - j) * 256 + k * 16 + k0 + q] : 0.f;
        } else { const int sidx = c8 - 512, im = sidx >> 6, p0 = sidx & 63;
#pragma unroll
            for (int q = 0; q < 8; ++q) { const int p = p0 + q; const float c_r = cr[k * 64 + p], c_i = ci[k * 64 + p], w_r = pwr[p * 34 + i + 1], w_i = pwi[p * 34 + i + 1];
                v[q] = im ? -(c_r * w_i + c_i * w_r) : (c_r * w_r - c_i * w_i); } }
        u32x4 o; o.x = pk2(v[0], v[1]); o.y = pk2(v[2], v[3]); o.z = pk2(v[4], v[5]); o.w = pk2(v[6], v[7]);
        *(GAS u32x4*)(T + (size_t)n * 640 + c8) = o; }
    bf16_t* WA = (bf16_t*)(F.ws + WS_S5WA) + (size_t)g * 256 * 512;
    for (int ch = tid; ch < 64 * 64; ch += NTHR) {
        const int rl = ch >> 6, c8 = (ch & 63) * 8, n = qd * 64 + rl, j = c8 >> 4, k0 = c8 & 15; float v[8];
        if (n < 128) { const int im = n >> 6, p = n & 63; const float w_r = pwr[p * 34 + 31 - j], w_i = pwi[p * 34 + 31 - j];
#pragma unroll
            for (int q = 0; q < 8; ++q) { const float b_r = bbr[p * 16 + k0 + q], b_i = bbi[p * 16 + k0 + q]; v[q] = im ? (w_r * b_i + w_i * b_r) : (w_r * b_r - w_i * b_i); }
        } else {
#pragma unroll
            for (int q = 0; q < 8; ++q) v[q] = 0.f; }
        u32x4 o; o.x = pk2(v[0], v[1]); o.y = pk2(v[2], v[3]); o.z = pk2(v[4], v[5]); o.w = pk2(v[6], v[7]);
        *(GAS u32x4*)(WA + (size_t)n * 512 + c8) = o; }
    if (qd == 0 && tid < 64) { float* al = (float*)(F.ws + WS_AL) + (size_t)(g * 64 + tid) * 2; al[0] = pwr[tid * 34 + 32]; al[1] = pwi[tid * 34 + 32]; }
    __syncthreads();
}
__device__ __forceinline__ void p0_prologue(Frame& F) {
    for (int job = blockIdx.x; job < 192; job += F.G) p0_mod_job(F, job);
    for (int job = blockIdx.x; job < 256; job += F.G) p0_s5_job(F, job);
    {
        float* wsk = (float*)(F.ws + WS_WSK);
        for (int i = blockIdx.x * NTHR + F.tid; i < 24 * 1024; i += F.G * NTHR) { const int c = i >> 10, k = i & 1023; wsk[i] = F.in[5][(size_t)k * INCOLS + (c < 8 ? 1536 + c : 3080 + c - 8)]; }
    }
    p0_transposes(F);
}
template <int MODE>
__device__ __forceinline__ void norm_mod_phase(Frame& F, const float* __restrict__ xsrc, const float* __restrict__ normw, const float* __restrict__ modv, bf16_t* __restrict__ hout) {
    LAS f32x2* tab = (LAS f32x2*)F.lds;
    LAS float* wx = (LAS float*)(F.lds + 32768);
    LAS int* wcnt = (LAS int*)(F.lds + 32768 + 98304);
    LAS int* wbase = wcnt + 64;
    for (int i = F.tid; i < 4096; i += NTHR) { const int b = i >> 10, c = i & 1023; tab[i] = (f32x2){normw[c] * (1.f + modv[b * 3072 + 1024 + c]), modv[b * 3072 + c]}; }
    if (MODE == 1) { const float* wsk = (const float*)(F.ws + WS_WSK); for (int i = F.tid; i < 24 * 1024; i += NTHR) wx[i] = wsk[i]; }
    if (MODE == 2) { const float* wr_ = F.in[34]; for (int i = F.tid; i < 8 * 1024; i += NTHR) { const int e = i >> 10, k = i & 1023; wx[i] = wr_[k * 8 + e]; } }
    __syncthreads();
    const int gw = F.vcu * NWAVES + F.wave, NGW = F.G * NWAVES, lane = F.lane;
    int cnt0 = 0, cnt1 = 0, cnt2 = 0, cnt3 = 0, cnt4 = 0, cnt5 = 0, cnt6 = 0, cnt7 = 0;
    unsigned* route = (unsigned*)(F.ws + WS_ROUTE);
    for (int m = gw; m < MTOK; m += NGW) {
        const GAS f32x4* xr = (const GAS f32x4*)(xsrc + (size_t)m * 1024) + lane;
        f32x4 v[4]; float ss = 0.f;
#pragma unroll
        for (int j = 0; j < 4; ++j) { v[j] = xr[64 * j]; ss += (v[j].x * v[j].x + v[j].y * v[j].y) + (v[j].z * v[j].z + v[j].w * v[j].w); }
        const float rinv = 1.f / sqrtf(wave_sum(ss) * (1.f / 1024.f) + EPS);
        const int b = m >> 12;
        GAS u32x2* o8 = (GAS u32x2*)(hout + (size_t)m * 1024) + lane;
#pragma unroll
        for (int j = 0; j < 4; ++j) { const int c = 4 * lane + 256 * j; const LAS f32x2* tb = tab + b * 1024 + c;
            const f32x2 t0 = tb[0], t1 = tb[1], t2 = tb[2], t3 = tb[3];
            v[j].x = v[j].x * rinv * t0.x + t0.y; v[j].y = v[j].y * rinv * t1.x + t1.y; v[j].z = v[j].z * rinv * t2.x + t2.y; v[j].w = v[j].w * rinv * t3.x + t3.y;
            o8[64 * j] = (u32x2){cvt_pk_bf16(v[j].x, v[j].y), cvt_pk_bf16(v[j].z, v[j].w)}; }
        if (MODE == 1) {
            float keep = 0.f;
#pragma unroll 4
            for (int c = 0; c < 24; ++c) { float p = 0.f;
#pragma unroll
                for (int j = 0; j < 4; ++j) { const f32x4 w = *(const LAS f32x4*)(wx + c * 1024 + 4 * lane + 256 * j); p += (v[j].x * w.x + v[j].y * w.y) + (v[j].z * w.z + v[j].w * w.w); }
                p = wave_sum(p); keep = (lane == c) ? p : keep; }
            if (lane < 24) ((float*)(F.ws + WS_FFGLR))[(size_t)m * 24 + lane] = keep;
        }
        if (MODE == 2) {
            float lg[8];
#pragma unroll
            for (int e = 0; e < 8; ++e) { float p = 0.f;
#pragma unroll
                for (int j = 0; j < 4; ++j) { const f32x4 w = *(const LAS f32x4*)(wx + e * 1024 + 4 * lane + 256 * j); p += (v[j].x * w.x + v[j].y * w.y) + (v[j].z * w.z + v[j].w * w.w); }
                lg[e] = wave_sum(p); }
            int e0 = 0; float v0 = lg[0];
#pragma unroll
            for (int e = 1; e < 8; ++e) if (lg[e] > v0) { v0 = lg[e]; e0 = e; }
            int e1 = -1; float v1 = -INFINITY;
#pragma unroll
            for (int e = 0; e < 8; ++e) if (e != e0 && lg[e] > v1) { v1 = lg[e]; e1 = e; }
            const float ex = expf(v1 - v0), w0 = 1.f / (1.f + ex), w1 = ex / (1.f + ex);
            if (lane == 0) { GAS u32x4* rp = (GAS u32x4*)(route + (size_t)m * 8); rp[0] = (u32x4){(unsigned)e0, (unsigned)e1, 0u, 0u}; rp[1] = (u32x4){__float_as_uint(w0), __float_as_uint(w1), 0u, 0u}; }
            cnt0 += (e0 == 0) + (e1 == 0); cnt1 += (e0 == 1) + (e1 == 1); cnt2 += (e0 == 2) + (e1 == 2); cnt3 += (e0 == 3) + (e1 == 3);
            cnt4 += (e0 == 4) + (e1 == 4); cnt5 += (e0 == 5) + (e1 == 5); cnt6 += (e0 == 6) + (e1 == 6); cnt7 += (e0 == 7) + (e1 == 7);
        }
    }
    if (MODE == 2) {
        if (lane < 8) { const int c = lane == 0 ? cnt0 : lane == 1 ? cnt1 : lane == 2 ? cnt2 : lane == 3 ? cnt3 : lane == 4 ? cnt4 : lane == 5 ? cnt5 : lane == 6 ? cnt6 : cnt7; wcnt[F.wave * 8 + lane] = c; }
        __syncthreads();
        if (F.tid < 8) { int tot = 0;
#pragma unroll
            for (int w = 0; w < 8; ++w) tot += wcnt[w * 8 + F.tid];
            int run = (int)__hip_atomic_fetch_add((unsigned*)(F.ctl + CW_ECNT + 64 * F.tid), (unsigned)tot, RLX_AGENT);
#pragma unroll
            for (int w = 0; w < 8; ++w) { wbase[w * 8 + F.tid] = run; run += wcnt[w * 8 + F.tid]; } }
        __syncthreads();
        if (lane == 0) { int* rowtok = (int*)(F.ws + WS_ROWTOK); VM_WAIT();
            for (int m = gw; m < MTOK; m += NGW) { unsigned* rp = route + (size_t)m * 8; const int e0 = (int)rp[0], e1 = (int)rp[1];
                const int s0 = wbase[F.wave * 8 + e0]; wbase[F.wave * 8 + e0] = s0 + 1; const int s1 = wbase[F.wave * 8 + e1]; wbase[F.wave * 8 + e1] = s1 + 1;
                rp[2] = (unsigned)s0; rp[3] = (unsigned)s1; rowtok[e0 * MTOK + s0] = m; rowtok[e1 * MTOK + s1] = m; } }
    }
    __syncthreads();
}

__device__ __forceinline__ void fox_cum_job(Frame& F, int bh) {
    const int b = bh >> 3, h = bh & 7, tid = F.tid; const float fb = F.in[6][h];
    const float* ff = (const float*)(F.ws + WS_FFGLR) + (size_t)(b * SEQ) * 24 + h;
    LAS float* wt = (LAS float*)F.lds;
    float v[8]; float run = 0.f;
#pragma unroll
    for (int i = 0; i < 8; ++i) { run += log_sigmoid_f(ff[(size_t)(tid * 8 + i) * 24] + fb); v[i] = run; }
    float inc = run;
#pragma unroll
    for (int o = 1; o < 64; o <<= 1) { const float t = __shfl_up(inc, o); if (F.lane >= o) inc += t; }
    if (F.lane == 63) wt[F.wave] = inc;
    __syncthreads();
    float off = inc - run;
    for (int w = 0; w < F.wave; ++w) off += wt[w];
    float* cum = (float*)(F.ws + WS_CUM) + (size_t)bh * SEQ + tid * 8;
#pragma unroll
    for (int i = 0; i < 8; ++i) cum[i] = (off + v[i]) * LOG2E;
    __syncthreads();
}

constexpr int GL_ST = 72;
struct GlaLds {
    LAS float* bL;
    LAS float* glr;
    LAS float* w2;
    LAS float* b2;
    LAS bf16_t* XA;
    LAS bf16_t* XB;
    LAS bf16_t* XP;
    LAS bf16_t* XV;
    LAS bf16_t* XS;
    LAS float* OL;
};
__device__ __forceinline__ GlaLds gla_lds(LAS unsigned char* lds) {
    GlaLds L; L.bL = (LAS float*)lds; L.glr = L.bL + 64 * 65; L.w2 = L.glr + 1024; L.b2 = L.w2 + 1024;
    L.XA = (LAS bf16_t*)(lds + 32768); L.XB = L.XA + 64 * GL_ST; L.XP = L.XB + 64 * GL_ST; L.XV = L.XP + 64 * GL_ST; L.XS = L.XV + 128 * GL_ST; L.OL = (LAS float*)L.XV; return L;
}
__device__ __forceinline__ void gla_decay(Frame& F, const GlaLds& L, int tok0, int hg) {
    const int tid = F.tid; const float* ffglr = (const float*)(F.ws + WS_FFGLR);
    for (int i = tid; i < 1024; i += NTHR) { const int t = i >> 4, r = i & 15; L.glr[i] = ffglr[(size_t)(tok0 + t) * 24 + 8 + r]; L.w2[i] = F.in[7][(i >> 6) * 256 + hg * 64 + (i & 63)]; }
    if (tid < 64) L.b2[tid] = F.in[8][hg * 64 + tid];
    __syncthreads();
    { const int t = tid >> 3, d0 = (tid & 7) * 8;
#pragma unroll
        for (int q = 0; q < 8; ++q) { const int d = d0 + q; float a = L.b2[d];
#pragma unroll
            for (int r = 0; r < 16; ++r) a += L.glr[t * 16 + r] * L.w2[r * 64 + d];
            L.bL[t * 65 + d] = log_sigmoid_f(a) * (1.f / 16.f); } }
    __syncthreads();
#pragma unroll
    for (int q = 0; q < 8; ++q) { const int d = F.wave * 8 + q; float x = L.bL[F.lane * 65 + d];
#pragma unroll
        for (int o = 1; o < 64; o <<= 1) { const float t = __shfl_up(x, o); if (F.lane >= o) x += t; }
        L.bL[F.lane * 65 + d] = x; }
    __syncthreads();
}
__device__ __forceinline__ bf16x8 lds_frag(const LAS bf16_t* X, int row, int k0) { return *(const LAS bf16x8*)(X + row * GL_ST + k0); }
__device__ __forceinline__ void gla_load_vT(Frame& F, const GlaLds& L, const bf16_t* qkv, int tok0, int hg) {
    const int s = F.tid >> 3, v0 = (F.tid & 7) * 16; const bf16_t* src = qkv + (size_t)(tok0 + s) * NQKV + 2048 + hg * 128 + v0;
    const u32x4 a = *(const u32x4*)src, b = *(const u32x4*)(src + 8); const unsigned w[8] = {a.x, a.y, a.z, a.w, b.x, b.y, b.z, b.w};
#pragma unroll
    for (int q = 0; q < 8; ++q) { L.XV[(v0 + 2 * q) * GL_ST + s] = (bf16_t)(w[q] & 0xffffu); L.XV[(v0 + 2 * q + 1) * GL_ST + s] = (bf16_t)(w[q] >> 16); }
}
__device__ __forceinline__ void gla1_unit(Frame& F, int unit) {
    const GlaLds L = gla_lds(F.lds); const int bh = unit >> 6, c = unit & 63, b = bh >> 2, hg = bh & 3, tok0 = b * SEQ + c * 64, tid = F.tid, lane = F.lane;
    const bf16_t* qkv = (const bf16_t*)(F.ws + WS_QKV);
    gla_decay(F, L, tok0, hg);
    { const int s = tid >> 3, d0 = (tid & 7) * 8; const u32x4 kk = *(const u32x4*)(qkv + (size_t)(tok0 + s) * NQKV + 1792 + hg * 64 + d0); const unsigned w[4] = {kk.x, kk.y, kk.z, kk.w};
#pragma unroll
        for (int q = 0; q < 4; ++q) { const int d = d0 + 2 * q;
            L.XA[d * GL_ST + s] = (bf16_t)f2bf(bf_lo(w[q]) * expf(L.bL[63 * 65 + d] - L.bL[s * 65 + d]));
            L.XA[(d + 1) * GL_ST + s] = (bf16_t)f2bf(bf_hi(w[q]) * expf(L.bL[63 * 65 + d + 1] - L.bL[s * 65 + d + 1])); } }
    gla_load_vT(F, L, qkv, tok0, hg);
    if (tid < 64) ((float*)(F.ws + WS_GLAEB))[(size_t)unit * 64 + tid] = expf(L.bL[63 * 65 + tid]);
    __syncthreads();
    { const int mb = F.wave >> 2, nb = F.wave & 3, r32 = lane & 31, hi = lane >> 5; f32x16 acc = {};
#pragma unroll
        for (int ks = 0; ks < 4; ++ks) acc = __builtin_amdgcn_mfma_f32_32x32x16_bf16(lds_frag(L.XA, mb * 32 + r32, ks * 16 + hi * 8), lds_frag(L.XV, nb * 32 + r32, ks * 16 + hi * 8), acc, 0, 0, 0);
        float* S = F.out + (size_t)unit * 8192;
#pragma unroll
        for (int r = 0; r < 16; ++r) S[(mb * 32 + (r & 3) + 8 * (r >> 2) + 4 * hi) * 128 + nb * 32 + r32] = acc[r]; }
    __syncthreads();
}
__device__ __forceinline__ void gla2_phase(Frame& F) {
    float* S = F.out; const float* eb = (const float*)(F.ws + WS_GLAEB);
    for (int e = blockIdx.x * NTHR + F.tid; e < 16 * 8192; e += F.G * NTHR) {
        const int bh = e >> 13, dv = e & 8191, d = dv >> 7; float st = 0.f;
        float* p = S + (size_t)bh * 64 * 8192 + dv; const float* q = eb + (size_t)bh * 64 * 64 + d;
#pragma unroll 8
        for (int c = 0; c < 64; ++c) { const float t = p[(size_t)c * 8192]; p[(size_t)c * 8192] = st; st = q[c * 64] * st + t; } }
}
__device__ __forceinline__ void gla3_unit(Frame& F, int unit) {
    const GlaLds L = gla_lds(F.lds); const int bh = unit >> 6, c = unit & 63, b = bh >> 2, hg = bh & 3, tok0 = b * SEQ + c * 64, tid = F.tid, lane = F.lane;
    const bf16_t* qkv = (const bf16_t*)(F.ws + WS_QKV);
    gla_decay(F, L, tok0, hg);
    { const int s = tid >> 3, d0 = (tid & 7) * 8; const bf16_t* rowp = qkv + (size_t)(tok0 + s) * NQKV + hg * 64 + d0;
        const u32x4 qq = *(const u32x4*)(rowp + 1536), kk = *(const u32x4*)(rowp + 1792); const unsigned wq[4] = {qq.x, qq.y, qq.z, qq.w}, wk[4] = {kk.x, kk.y, kk.z, kk.w}; unsigned oq[4], ok[4];
#pragma unroll
        for (int q = 0; q < 4; ++q) { const float b0 = L.bL[s * 65 + d0 + 2 * q], b1 = L.bL[s * 65 + d0 + 2 * q + 1];
            oq[q] = pk2(bf_lo(wq[q]) * 0.125f * expf(b0), bf_hi(wq[q]) * 0.125f * expf(b1)); ok[q] = pk2(bf_lo(wk[q]) * expf(-b0), bf_hi(wk[q]) * expf(-b1)); }
        *(LAS u32x4*)(L.XA + s * GL_ST + d0) = (u32x4){oq[0], oq[1], oq[2], oq[3]}; *(LAS u32x4*)(L.XB + s * GL_ST + d0) = (u32x4){ok[0], ok[1], ok[2], ok[3]}; }
    gla_load_vT(F, L, qkv, tok0, hg);
    { const int d = tid >> 3, v0 = (tid & 7) * 16; const float* S = F.out + (size_t)unit * 8192 + d * 128 + v0;
#pragma unroll
        for (int q = 0; q < 4; ++q) { const f32x4 x = *(const f32x4*)(S + 4 * q);
            L.XS[(v0 + 4 * q) * GL_ST + d] = (bf16_t)f2bf(x.x); L.XS[(v0 + 4 * q + 1) * GL_ST + d] = (bf16_t)f2bf(x.y); L.XS[(v0 + 4 * q + 2) * GL_ST + d] = (bf16_t)f2bf(x.z); L.XS[(v0 + 4 * q + 3) * GL_ST + d] = (bf16_t)f2bf(x.w); } }
    __syncthreads();
    const int r32 = lane & 31, hi = lane >> 5;
    if (F.wave < 4) { const int mb = F.wave >> 1, nb = F.wave & 1; f32x16 acc = {};
#pragma unroll
        for (int ks = 0; ks < 4; ++ks) acc = __builtin_amdgcn_mfma_f32_32x32x16_bf16(lds_frag(L.XA, mb * 32 + r32, ks * 16 + hi * 8), lds_frag(L.XB, nb * 32 + r32, ks * 16 + hi * 8), acc, 0, 0, 0);
#pragma unroll
        for (int r = 0; r < 16; ++r) { const int t = mb * 32 + (r & 3) + 8 * (r >> 2) + 4 * hi, s = nb * 32 + r32; L.XP[t * GL_ST + s] = (bf16_t)f2bf(s <= t ? acc[r] : 0.f); } }
    __syncthreads();
    f32x16 acc = {};
    { const int mb = F.wave >> 2, nb = F.wave & 3;
#pragma unroll
        for (int ks = 0; ks < 4; ++ks) acc = __builtin_amdgcn_mfma_f32_32x32x16_bf16(lds_frag(L.XP, mb * 32 + r32, ks * 16 + hi * 8), lds_frag(L.XV, nb * 32 + r32, ks * 16 + hi * 8), acc, 0, 0, 0);
#pragma unroll
        for (int ks = 0; ks < 4; ++ks) acc = __builtin_amdgcn_mfma_f32_32x32x16_bf16(lds_frag(L.XA, mb * 32 + r32, ks * 16 + hi * 8), lds_frag(L.XS, nb * 32 + r32, ks * 16 + hi * 8), acc, 0, 0, 0);
    }
    __syncthreads();
    { const int mb = F.wave >> 2, nb = F.wave & 3;
#pragma unroll
        for (int r = 0; r < 16; ++r) L.OL[(mb * 32 + (r & 3) + 8 * (r >> 2) + 4 * hi) * 132 + nb * 32 + r32] = acc[r]; }
    __syncthreads();
    { const int t = tid >> 3, v0 = (tid & 7) * 16; float o[16]; float ss = 0.f;
#pragma unroll
        for (int q = 0; q < 4; ++q) { const f32x4 x = *(const LAS f32x4*)(L.OL + t * 132 + v0 + 4 * q); o[4 * q] = x.x; o[4 * q + 1] = x.y; o[4 * q + 2] = x.z; o[4 * q + 3] = x.w; ss += (x.x * x.x + x.y * x.y) + (x.z * x.z + x.w * x.w); }
        ss += __shfl_xor(ss, 1); ss += __shfl_xor(ss, 2); ss += __shfl_xor(ss, 4);
        const float rinv = 1.f / sqrtf(ss * (1.f / 128.f) + EPS);
        const bf16_t* gp = qkv + (size_t)(tok0 + t) * NQKV + 2560 + hg * 128 + v0; const u32x4 g0 = *(const u32x4*)gp, g1 = *(const u32x4*)(gp + 8);
        const unsigned gw_[8] = {g0.x, g0.y, g0.z, g0.w, g1.x, g1.y, g1.z, g1.w}; const float* gn = F.in[9] + v0; unsigned ow[8];
#pragma unroll
        for (int q = 0; q < 8; ++q) { const float a = o[2 * q] * rinv * gn[2 * q] * silu_f(bf_lo(gw_[q])), bb = o[2 * q + 1] * rinv * gn[2 * q + 1] * silu_f(bf_hi(gw_[q])); ow[q] = cvt_pk_bf16(a, bb); }
        bf16_t* mp = (bf16_t*)(F.ws + WS_MIX) + (size_t)(tok0 + t) * 1024 + 512 + hg * 128 + v0;
        *(u32x4*)mp = (u32x4){ow[0], ow[1], ow[2], ow[3]}; *(u32x4*)(mp + 8) = (u32x4){ow[4], ow[5], ow[6], ow[7]}; }
    __syncthreads();
}

__device__ __forceinline__ void s5_scan_job(Frame& F, int job) {
    const int g = job >> 2, b = job & 3, p = F.lane, seg = F.wave;
    const float* E = (const float*)(F.ws + WS_E) + ((size_t)(g * 512 + b * 128 + seg * 16)) * 128 + p;
    bf16_t* AU = (bf16_t*)(F.ws + WS_AU) + ((size_t)(g * 512 + b * 128 + seg * 16)) * 640 + 512 + p;
    const float* al = (const float*)(F.ws + WS_AL) + (size_t)(g * 64 + p) * 2; const float ar = al[0], ai = al[1];
    LAS float* se = (LAS float*)F.lds;
    float er[16], ei[16];
#pragma unroll
    for (int k = 0; k < 16; ++k) { er[k] = E[(size_t)k * 128]; ei[k] = E[(size_t)k * 128 + 64]; }
    float sr = 0.f, si = 0.f;
#pragma unroll
    for (int k = 0; k < 16; ++k) { const float nr = ar * sr - ai * si + er[k], ni = ar * si + ai * sr + ei[k]; sr = nr; si = ni; }
    se[(seg * 64 + p) * 2] = sr; se[(seg * 64 + p) * 2 + 1] = si;
    float pr = ar, pi = ai;
#pragma unroll
    for (int q = 0; q < 4; ++q) { const float nr = pr * pr - pi * pi, ni = 2.f * pr * pi; pr = nr; pi = ni; }
    __syncthreads();
    sr = 0.f; si = 0.f;
    for (int j = 0; j < seg; ++j) { const float xr = se[(j * 64 + p) * 2], xi = se[(j * 64 + p) * 2 + 1]; const float nr = pr * sr - pi * si + xr, ni = pr * si + pi * sr + xi; sr = nr; si = ni; }
#pragma unroll
    for (int k = 0; k < 16; ++k) { AU[(size_t)k * 640] = (bf16_t)f2bf(sr); AU[(size_t)k * 640 + 64] = (bf16_t)f2bf(si);
        const float nr = ar * sr - ai * si + er[k], ni = ar * si + ai * sr + ei[k]; sr = nr; si = ni; }
    __syncthreads();
}

__device__ __forceinline__ void moe_tile_starts(Frame& F, int* ts, int* cnt) {
    int run = 0;
#pragma unroll
    for (int e = 0; e < 8; ++e) { const int c = (int)__hip_atomic_load((unsigned*)(F.ctl + CW_ECNT + 64 * e), RLX_AGENT); cnt[e] = c; ts[e] = run; run += (c + 255) >> 8; }
    ts[8] = run;
}
template <bool MOE>
__device__ __forceinline__ void final_phase(Frame& F, const float* xsrc) {
    const int gw = F.vcu * NWAVES + F.wave, NGW = F.G * NWAVES, lane = F.lane;
    int ts[9], cnt[8]; if (MOE) moe_tile_starts(F, ts, cnt);
    const unsigned* route = (const unsigned*)(F.ws + WS_ROUTE); const bf16_t* yp = (const bf16_t*)(F.ws + WS_YPERM);
    const float* gate = (const float*)(F.ws + WS_MOD) + (size_t)3 * 4 * 3072 + 2048; const float* fw = F.in[38];
    for (int m = gw; m < MTOK; m += NGW) {
        const GAS f32x4* xr = (const GAS f32x4*)(xsrc + (size_t)m * 1024) + lane; f32x4 v[4];
#pragma unroll
        for (int j = 0; j < 4; ++j) v[j] = xr[64 * j];
        if (MOE) {
            const u32x4 r0 = *(const u32x4*)(route + (size_t)m * 8), r1 = *(const u32x4*)(route + (size_t)m * 8 + 4);
            const int e0 = (int)r0.x, e1 = (int)r0.y; const float w0 = __uint_as_float(r1.x), w1 = __uint_as_float(r1.y);
            int t0 = 0, t1 = 0;
#pragma unroll
            for (int e = 0; e < 8; ++e) { t0 = (e == e0) ? ts[e] : t0; t1 = (e == e1) ? ts[e] : t1; }
            const bf16_t* y0 = yp + (size_t)(t0 * 256 + (int)r0.z) * 1024, * y1 = yp + (size_t)(t1 * 256 + (int)r0.w) * 1024; const float* gv = gate + (size_t)(m >> 12) * 3072;
#pragma unroll
            for (int j = 0; j < 4; ++j) { const int c = 4 * lane + 256 * j; const u32x2 a = *(const u32x2*)(y0 + c), bq = *(const u32x2*)(y1 + c); const f32x4 gg = *(const f32x4*)(gv + c);
                v[j].x += gg.x * (w0 * bf_lo(a.x) + w1 * bf_lo(bq.x)); v[j].y += gg.y * (w0 * bf_hi(a.x) + w1 * bf_hi(bq.x)); v[j].z += gg.z * (w0 * bf_lo(a.y) + w1 * bf_lo(bq.y)); v[j].w += gg.w * (w0 * bf_hi(a.y) + w1 * bf_hi(bq.y)); }
        }
        float ss = 0.f;
#pragma unroll
        for (int j = 0; j < 4; ++j) ss += (v[j].x * v[j].x + v[j].y * v[j].y) + (v[j].z * v[j].z + v[j].w * v[j].w);
        const float rinv = 1.f / sqrtf(wave_sum(ss) * (1.f / 1024.f) + EPS);
        GAS f32x4* op = (GAS f32x4*)(F.out + (size_t)m * 1024) + lane;
#pragma unroll
        for (int j = 0; j < 4; ++j) { const f32x4 w = *(const f32x4*)(fw + 4 * lane + 256 * j); op[64 * j] = v[j] * rinv * w; }
    }
}
#ifndef MK_LAUNCH_PER_PHASE
#define MK_LAUNCH_PER_PHASE 0
#endif
#ifndef MK_STAGE
#define MK_STAGE 4
#endif
constexpr int NPHASE = 21;
struct Args { const float* in[39]; float* out; unsigned char* ws; int ph_lo, ph_hi; };
static_assert(sizeof(Args) == 39 * 8 + 8 + 8 + 8, "Args has no padding");

__global__ void __launch_bounds__(NTHR, 2) trunk_fwd(Args args) {
    extern __shared__ __attribute__((aligned(16))) unsigned char lds_raw[];
    Frame F;
    F.lds = (LAS unsigned char*)lds_raw;
    F.tid = threadIdx.x; F.lane = F.tid & 63; F.wave = __builtin_amdgcn_readfirstlane(F.tid >> 6);
    F.G = gridDim.x; { const int bx = blockIdx.x; F.vcu = (F.G % 8 == 0) ? (bx % 8) * (F.G / 8) + bx / 8 : bx; }
    F.ws = args.ws; F.out = args.out; F.ctl = (gu32*)(args.ws + WS_CTL);
    F.in = args.in;
    volatile LAS unsigned* MISC = (volatile LAS unsigned*)(F.lds + MISC_OFF);
    if (F.tid < 64) MISC[F.tid] = 0u;
    __syncthreads();
    if (!MK_LAUNCH_PER_PHASE) (void)xcd_barrier_post((unsigned*)(F.ctl + CW_BAR), MISC + 8);
#ifndef MK_ONLY
#define MK_ONLY -1
#endif
    const int lo = args.ph_lo, hi = args.ph_hi;
#define IN(k) ((MK_ONLY < 0 || (k) == MK_ONLY) && lo <= (k) && (k) < hi)
#if MK_LAUNCH_PER_PHASE
#define SEAM(k) do { } while (0)
#else
#define SEAM(k) do { XcdBarrier b_; b_.bar = (unsigned*)((gu32*)F.ws + CW_BAR); b_.x = xb_xcc_id(); b_.st = (volatile LAS unsigned*)(F.lds + MISC_OFF) + 8; xcd_barrier(b_); } while (0)
#endif
    unsigned char* ws = F.ws;
    const float* modv = (const float*)(ws + WS_MOD);
    bf16_t* const H = (bf16_t*)(ws + WS_H);
    const LAS unsigned* gtab = (const LAS unsigned*)(F.lds + GTAB_OFF);
    char* const ldsg = (char*)lds_raw;

    if (IN(0)) { p0_prologue(F); SEAM(0); }
#if MK_STAGE >= 1
    if (IN(1)) { norm_mod_phase<1>(F, F.in[0], F.in[2], modv + 0 * 12288, H); SEAM(1); }
    if (IN(2)) { pg8::Gemm g{H, (const bf16_t*)(ws + WS_WIN0), 1024, 1024, 0, 0}; pg8::StaticOrder S; S.init(MTOK / 256, NQKV / 256, 1, F.G, (int)blockIdx.x);
        pg8::EpiBf16 E{(bf16_t*)(ws + WS_QKV), NQKV, 2, attn_body::C2};
        pg8::gemm_phase<pg8::EpiBf16, pg8::StaticOrder, true, false>(F.lds, g, S, E, gtab); SEAM(2); }
    if (IN(3)) { for (int j = blockIdx.x; j < 32; j += F.G) fox_cum_job(F, j);
        for (int u = blockIdx.x; u < 1024; u += F.G) gla1_unit(F, u); SEAM(3); }
    if (IN(4)) { gla2_phase(F); SEAM(4); }
    if (IN(5)) { for (int u = blockIdx.x; u < 1024; u += F.G) gla3_unit(F, u);
        const attn_body::bf16* qkv = (const attn_body::bf16*)(ws + WS_QKV);
        const attn_body::AttnTensors AT{qkv, qkv + 512, qkv + 1024, (attn_body::bf16*)(ws + WS_MIX), (const float*)(ws + WS_CUM)};
        const attn_body::StaticOrder S((int)F.G, (int)blockIdx.x);
        attn_body::attn_phase<attn_body::StaticOrder>(ldsg, AT, S); SEAM(5); }
    if (IN(6)) { pg8::Gemm g{(const bf16_t*)(ws + WS_MIX), (const bf16_t*)(ws + WS_WO0), 1024, 1024, 0, 0}; pg8::StaticOrder S; S.init(MTOK / 256, 4, 1, F.G, (int)blockIdx.x);
        pg8::EpiResid E{F.in[0], F.out, modv + 0 * 12288 + 2048};
        pg8::gemm_phase<pg8::EpiResid, pg8::StaticOrder, false, false>(F.lds, g, S, E, gtab); SEAM(6); }
#endif
#if MK_STAGE >= 2
    if (IN(7)) { norm_mod_phase<0>(F, F.out, F.in[11], modv + 1 * 12288, H); SEAM(7); }
    if (IN(8)) { pg8::Gemm g{H, (const bf16_t*)(ws + WS_WGU0), 1024, 1024, 0, 0}; pg8::StaticOrder S; S.init(MTOK / 256, 22, 1, F.G, (int)blockIdx.x);
        pg8::EpiSwiGLU E{(bf16_t*)(ws + WS_ACT), DFF};
        pg8::gemm_phase<pg8::EpiSwiGLU, pg8::StaticOrder, true, false>(F.lds, g, S, E, gtab); SEAM(8); }
    if (IN(9)) { pg8::Gemm g{(const bf16_t*)(ws + WS_ACT), (const bf16_t*)(ws + WS_WD0), DFF, DFF, 0, 0}; pg8::StaticOrder S; S.init(MTOK / 256, 4, 1, F.G, (int)blockIdx.x);
        pg8::EpiResid E{F.out, F.out, modv + 1 * 12288 + 2048};
        pg8::gemm_phase<pg8::EpiResid, pg8::StaticOrder, false, false>(F.lds, g, S, E, gtab); SEAM(9); }
#endif
#if MK_STAGE >= 3
    if (IN(10)) { norm_mod_phase<0>(F, F.out, F.in[17], modv + 2 * 12288, H); SEAM(10); }
    if (IN(11)) { pg8::Gemm g{H, (const bf16_t*)(ws + WS_WIN1), 1024, 1024, 0, 0}; pg8::StaticOrder S; S.init(MTOK / 256, 4, 1, F.G, (int)blockIdx.x);
        pg8::EpiS5U E{(bf16_t*)(ws + WS_AU)};
        pg8::gemm_phase<pg8::EpiS5U, pg8::StaticOrder, false, false>(F.lds, g, S, E, gtab); SEAM(11); }
    if (IN(12)) { pg8::Gemm g{(const bf16_t*)(ws + WS_AU), (const bf16_t*)(ws + WS_S5WA), 640, 512, (size_t)512 * 640, (size_t)256 * 512}; pg8::StaticOrder S; S.init(2, 1, 64, F.G, (int)blockIdx.x);
        pg8::EpiS5E E{(float*)(ws + WS_E)};
        pg8::gemm_phase<pg8::EpiS5E, pg8::StaticOrder, false, false>(F.lds, g, S, E, gtab); SEAM(12); }
    if (IN(13)) { for (int j = blockIdx.x; j < 256; j += F.G) s5_scan_job(F, j); SEAM(13); }
    if (IN(14)) { pg8::Gemm g{(const bf16_t*)(ws + WS_AU), (const bf16_t*)(ws + WS_S5T), 640, 640, (size_t)512 * 640, (size_t)512 * 640}; pg8::StaticOrder S; S.init(2, 2, 64, F.G, (int)blockIdx.x);
        pg8::EpiS5Y E{(const bf16_t*)(ws + WS_AU), F.in[28], (bf16_t*)(ws + WS_YG)};
        pg8::gemm_phase<pg8::EpiS5Y, pg8::StaticOrder, false, false>(F.lds, g, S, E, gtab); SEAM(14); }
    if (IN(15)) { pg8::Gemm g{(const bf16_t*)(ws + WS_YG), (const bf16_t*)(ws + WS_WGLU), 1024, 1024, 0, 0}; pg8::StaticOrder S; S.init(MTOK / 256, 4, 1, F.G, (int)blockIdx.x);
        pg8::EpiGlu E{(const bf16_t*)(ws + WS_YG), (bf16_t*)(ws + WS_Z)};
        pg8::gemm_phase<pg8::EpiGlu, pg8::StaticOrder, false, false>(F.lds, g, S, E, gtab); SEAM(15); }
    if (IN(16)) { pg8::Gemm g{(const bf16_t*)(ws + WS_Z), (const bf16_t*)(ws + WS_WO1), 1024, 1024, 0, 0}; pg8::StaticOrder S; S.init(MTOK / 256, 4, 1, F.G, (int)blockIdx.x);
        pg8::EpiResid E{F.out, F.out, modv + 2 * 12288 + 2048};
        pg8::gemm_phase<pg8::EpiResid, pg8::StaticOrder, false, false>(F.lds, g, S, E, gtab); SEAM(16); }
#endif
#if MK_STAGE >= 4
    if (IN(17)) { norm_mod_phase<2>(F, F.out, F.in[31], modv + 3 * 12288, (bf16_t*)(ws + WS_H3)); SEAM(17); }
    if (IN(18)) { int ts[9], cnt[8]; moe_tile_starts(F, ts, cnt);
        pg8::MoeOrder S; S.init(ts, 22, F.G, (int)blockIdx.x);
        {
            LAS unsigned* gt = (LAS unsigned*)(F.lds + GTAB_OFF); const int* rowtok = (const int*)(ws + WS_ROWTOK); pg8::Unit u;
            for (int i = 0; i < 16 && S.next(i, u); ++i) if (F.tid < 256) { int base = 0, c = 0;
#pragma unroll
                for (int e = 0; e < 8; ++e) { base = (u.bt == e) ? ts[e] : base; c = (u.bt == e) ? cnt[e] : c; }
                const int sl = (u.pm - base) * 256 + F.tid; const int tok = (sl < c) ? rowtok[u.bt * MTOK + sl] : 0; gt[i * 256 + F.tid] = (unsigned)tok * 2048u; }
            __syncthreads(); }
        pg8::Gemm g{(const bf16_t*)(ws + WS_H3), (const bf16_t*)(ws + WS_WEGU), 1024, 1024, 0, (size_t)5632 * 1024};
        pg8::EpiSwiGLU E{(bf16_t*)(ws + WS_ACTP), DFF};
        pg8::gemm_phase<pg8::EpiSwiGLU, pg8::MoeOrder, true, true>(F.lds, g, S, E, gtab); SEAM(18); }
    if (IN(19)) { int ts[9], cnt[8]; moe_tile_starts(F, ts, cnt);
        pg8::MoeOrder S; S.init(ts, 4, F.G, (int)blockIdx.x);
        pg8::Gemm g{(const bf16_t*)(ws + WS_ACTP), (const bf16_t*)(ws + WS_WED), DFF, DFF, 0, (size_t)1024 * DFF};
        pg8::EpiBf16 E{(bf16_t*)(ws + WS_YPERM), 1024, 0, 1.f};
        pg8::gemm_phase<pg8::EpiBf16, pg8::MoeOrder, false, false>(F.lds, g, S, E, gtab); SEAM(19); }
#endif
    if (IN(20)) {
#if MK_STAGE >= 4
        final_phase<true>(F, F.out);
#elif MK_STAGE >= 1
        final_phase<false>(F, F.out);
#else
        final_phase<false>(F, F.in[0]);
#endif
    }
#undef IN
#undef SEAM
}

extern "C" void kernel_launch(void* const* d_in, const int* in_sizes, int n_in, void* d_out, int out_size, void* d_ws, size_t ws_size, hipStream_t stream) {
    static int grid = 0;
    if (grid == 0) {
        if (n_in != 39 || in_sizes[0] != MTOK * DMODEL || out_size != MTOK * DMODEL || ws_size < WS_END) {
            fprintf(stderr, "kernel_launch: shape/workspace mismatch: n_in %d in0 %d out %d ws %zu (need %zu); nothing launched\n", n_in, n_in > 0 ? in_sizes[0] : -1, out_size, ws_size, (size_t)WS_END); grid = -1; return; }
        int dev = 0, cus = 0, per_cu = 0;
        if (hipGetDevice(&dev) != hipSuccess || hipDeviceGetAttribute(&cus, hipDeviceAttributeMultiprocessorCount, dev) != hipSuccess) { grid = -1; return; }
        if (hipFuncSetAttribute((const void*)trunk_fwd, hipFuncAttributeMaxDynamicSharedMemorySize, LDS_BYTES) != hipSuccess) { fprintf(stderr, "kernel_launch: hipFuncSetAttribute failed\n"); grid = -1; return; }
        if (hipOccupancyMaxActiveBlocksPerMultiprocessor(&per_cu, (const void*)trunk_fwd, NTHR, LDS_BYTES) != hipSuccess || per_cu < 1)
            fprintf(stderr, "kernel_launch: note: occupancy query reports %d workgroups per CU\n", per_cu);
        (void)hipGetLastError();
        grid = cus;
    }
    if (grid < 0) return;
    if (hipMemsetAsync((char*)d_ws + WS_CTL, 0, CTL_ZERO_BYTES, stream) != hipSuccess) return;
    Args a{};
    for (int i = 0; i < 39; ++i) a.in[i] = (const float*)d_in[i];
    a.out = (float*)d_out; a.ws = (unsigned char*)d_ws;
#if MK_LAUNCH_PER_PHASE
    for (int p = 0; p < NPHASE; ++p) { a.ph_lo = p; a.ph_hi = p + 1; hipLaunchKernelGGL(trunk_fwd, dim3(grid), dim3(NTHR), LDS_BYTES, stream, a); }
#else
    a.ph_lo = 0; a.ph_hi = NPHASE; hipLaunchKernelGGL(trunk_fwd, dim3(grid), dim3(NTHR), LDS_BYTES, stream, a);
#endif
}
```

```cpp
#define MK_LAUNCH_PER_PHASE 0
#define MK_STAGE 4
#include <hip/hip_runtime.h>
#include <hip/hip_bf16.h>
#include <cstdio>
#include <cstdint>
#include <cmath>

#define LAS __attribute__((address_space(3)))
#define GAS __attribute__((address_space(1)))
typedef unsigned short bf16_t;
typedef short bf16x8 __attribute__((ext_vector_type(8)));
typedef float f32x4 __attribute__((ext_vector_type(4)));
typedef float f32x2 __attribute__((ext_vector_type(2)));
typedef float f32x16 __attribute__((ext_vector_type(16)));
typedef unsigned u32x4 __attribute__((ext_vector_type(4)));
typedef unsigned u32x2 __attribute__((ext_vector_type(2)));

__device__ __forceinline__ unsigned cvt_pk_bf16(float lo, float hi) { unsigned r; asm volatile("v_cvt_pk_bf16_f32 %0, %1, %2" : "=v"(r) : "v"(lo), "v"(hi)); return r; }
__device__ __forceinline__ float bf_lo(unsigned w) { return __uint_as_float(w << 16); }
__device__ __forceinline__ float bf_hi(unsigned w) { return __uint_as_float(w & 0xffff0000u); }
__device__ __forceinline__ float fast_exp(float x) { return __builtin_amdgcn_exp2f(x * 1.4426950408889634f); }
__device__ __forceinline__ float fast_sigmoid(float x) { return __builtin_amdgcn_rcpf(1.0f + fast_exp(-x)); }
__device__ __forceinline__ float silu_f(float x) { return x * fast_sigmoid(x); }
__device__ __forceinline__ float gelu_tanh_f(float y) { const float t = 1.5957691216057308f * (y + 0.044715f * y * y * y); return y * fast_sigmoid(t); }

namespace pg8 {
constexpr int BM = 256, BK = 64, HALF = 128, HTB = HALF * BK * 2, STAGE_BYTES = 8 * HTB, NXCD = 8, WGM = 8;
__host__ __device__ __forceinline__ int lds_byte(int r, int c) { const int st = (r >> 4) * 2 + (c >> 5), rr = r & 15, cc = c & 31, ob = rr * 64 + cc * 2; return st * 1024 + (ob ^ (((ob >> 9) & 1) << 5)); }
__host__ __device__ __forceinline__ void stage_rc(int b, int& R, int& C) { const int st = b / 1024, sb = b % 1024, swz = sb ^ (((sb >> 9) & 1) << 5); R = (st >> 1) * 16 + swz / 64; C = (st & 1) * 32 + (swz % 64) / 2; }
__host__ __device__ __forceinline__ int perm32(int rho) { const int n = rho >> 4, i = rho & 15; return 8 * (i >> 2) + 4 * n + (i & 3); }

struct Unit { int pm, pn, bt; };
struct Gemm { const bf16_t* A; const bf16_t* Bt; int lda, K; size_t sA, sB; };

struct StaticOrder {
    int nM, nN, nwg, G, c;
    __device__ __forceinline__ void init(int nM_, int nN_, int nb, int G_, int c_) { nM = nM_; nN = nN_; nwg = nM * nN * nb; G = G_; c = c_; }
    __device__ __forceinline__ bool next(int i, Unit& u) const {
        const long L = (long)i * G + c; if (L >= nwg) return false;
        int wgid = (int)L; { const int q = nwg / NXCD, r = nwg % NXCD, xcd = wgid % NXCD, off = wgid / NXCD; wgid = (xcd < r ? xcd * (q + 1) : r * (q + 1) + (xcd - r) * q) + off; }
        const int per = nM * nN; u.bt = wgid / per; wgid -= u.bt * per;
        const int nig = WGM * nN, gid = wgid / nig, fm = gid * WGM, gsz = (nM - fm) < WGM ? (nM - fm) : WGM;
        u.pm = fm + ((wgid % nig) % gsz); u.pn = (wgid % nig) / gsz; return true;
    }
};
struct MoeOrder {
    int nN, nwg, G, c, nM; int ts[9];
    __device__ __forceinline__ void init(const int* tstart, int nN_, int G_, int c_) {
#pragma unroll
        for (int e = 0; e < 9; ++e) ts[e] = tstart[e];
        nM = ts[8]; nN = nN_; nwg = nM * nN; G = G_; c = c_; }
    __device__ __forceinline__ bool next(int i, Unit& u) const {
        const long L = (long)i * G + c; if (L >= nwg) return false;
        int wgid = (int)L; { const int q = nwg / NXCD, r = nwg % NXCD, xcd = wgid % NXCD, off = wgid / NXCD; wgid = (xcd < r ? xcd * (q + 1) : r * (q + 1) + (xcd - r) * q) + off; }
        const int nig = WGM * nN, gid = wgid / nig, fm = gid * WGM, gsz = (nM - fm) < WGM ? (nM - fm) : WGM;
        u.pm = fm + ((wgid % nig) % gsz); u.pn = (wgid % nig) / gsz;
        int e = 0;
#pragma unroll
        for (int k = 1; k < 8; ++k) e += (u.pm >= ts[k]) ? 1 : 0;
        u.bt = e; return true;
    }
};

template <class Epi, class Sched, bool ALIGN_EPI, bool GATHER>
__device__ __forceinline__ void gemm_phase(LAS unsigned char* lds, const Gemm g, const Sched& S, const Epi& E, const LAS unsigned* gtab) {
    const int tid = threadIdx.x, wid = __builtin_amdgcn_readfirstlane(tid >> 6), lane = tid & 63, wr = wid >> 2, wc = wid & 3, fr = lane & 15, fq = lane >> 4;
    const int K = g.K, nt = K / BK, lda = g.lda;
    unsigned voffB[2], oA[2][2], oN[2][2]; int Rr[2], Cc[2];
    const size_t hstepA = (size_t)HALF * lda * 2, hstepB = (size_t)HALF * K * 2;
#pragma unroll
    for (int i = 0; i < 2; ++i) { int R, C; stage_rc(tid * 16 + i * 8192, R, C); const int Rb = Epi::PERM ? ((R & ~31) + perm32(R & 31)) : R; Rr[i] = R; Cc[i] = C;
        voffB[i] = (unsigned)(Rb * K + C) * 2u; oA[0][i] = (unsigned)(R * lda + C) * 2u; oA[1][i] = oA[0][i] + (unsigned)hstepA; oN[0][i] = oA[0][i]; oN[1][i] = oA[1][i]; }
    const size_t kstep = (size_t)(BK * 2);
    const size_t tstepA = 2 * hstepA, tstepB = 2 * hstepB;
    const unsigned ldsw = (unsigned)wid * 1024u;
    const int aoff = lds_byte(wr * 64 + fr, fq * 8), boff = lds_byte(wc * 32 + fr, fq * 8);
#define PG8_SA(b, h) (((b) * 2 + (h)) * HTB)
#define PG8_SB(b, h) ((4 + (b) * 2 + (h)) * HTB)
#define PG8_STAGE(bufoff, gbase, voff) do { _Pragma("unroll") for (int _i = 0; _i < 2; ++_i) \
        __builtin_amdgcn_global_load_lds((const unsigned*)((const char*)(gbase) + (voff)[_i]), (LAS unsigned*)(lds + (bufoff) + ldsw + _i * 8192), 16, 0, 0); } while (0)
#define PG8_LDA(dst, b, h) do { _Pragma("unroll") for (int m = 0; m < 4; ++m) _Pragma("unroll") for (int k = 0; k < 2; ++k) dst[m][k] = *(const LAS bf16x8*)(lds + PG8_SA(b, h) + aoff + m * 2048 + k * 1024); } while (0)
#define PG8_LDB(dst, b, h) do { _Pragma("unroll") for (int n = 0; n < 2; ++n) _Pragma("unroll") for (int k = 0; k < 2; ++k) dst[n][k] = *(const LAS bf16x8*)(lds + PG8_SB(b, h) + boff + n * 2048 + k * 1024); } while (0)
#define PG8_MMA(ai, bj, At, Bt) do { __builtin_amdgcn_s_setprio(1); _Pragma("unroll") for (int m = 0; m < 4; ++m) _Pragma("unroll") for (int n = 0; n < 2; ++n) _Pragma("unroll") for (int k = 0; k < 2; ++k) \
        acc[ai][bj][m][n] = __builtin_amdgcn_mfma_f32_16x16x32_bf16(Bt[n][k], At[m][k], acc[ai][bj][m][n], 0, 0, 0); __builtin_amdgcn_s_setprio(0); } while (0)
#define PG8_WAIT_V(n) asm volatile("s_waitcnt vmcnt(" #n ")" ::: "memory")
#define PG8_WAIT_L(n) asm volatile("s_waitcnt lgkmcnt(" #n ")" ::: "memory")
#define PG8_BAR __builtin_amdgcn_s_barrier()
#define PG8_SCHED __builtin_amdgcn_sched_barrier(0)
#define PG8_GOFF(dst, ord) do { if constexpr (GATHER) { _Pragma("unroll") for (int _h = 0; _h < 2; ++_h) _Pragma("unroll") for (int _i = 0; _i < 2; ++_i) dst[_h][_i] = gtab[(ord) * 256 + Rr[_i] + 128 * _h] + (unsigned)Cc[_i] * 2u; } } while (0)
    Unit cur, nxt; int ui = 0;
    if (!S.next(0, cur)) return;
    f32x4 acc[2][2][4][2];
#pragma unroll
    for (int a = 0; a < 2; ++a)
#pragma unroll
        for (int b = 0; b < 2; ++b)
#pragma unroll
            for (int m = 0; m < 4; ++m)
#pragma unroll
                for (int n = 0; n < 2; ++n) acc[a][b][m][n] = (f32x4){0.f, 0.f, 0.f, 0.f};
    bf16x8 At[4][2], B0[2][2], B1[2][2];
    const char* cA = (const char*)g.A + (GATHER ? (size_t)0 : ((size_t)cur.bt * g.sA * 2 + (size_t)cur.pm * tstepA));
    const char* cB = (const char*)g.Bt + (size_t)cur.bt * g.sB * 2 + (size_t)cur.pn * tstepB;
    PG8_GOFF(oA, 0);
    PG8_STAGE(PG8_SB(0, 0), cB, voffB); PG8_STAGE(PG8_SB(0, 1), cB + hstepB, voffB); PG8_STAGE(PG8_SA(0, 0), cA, oA[0]); PG8_STAGE(PG8_SA(0, 1), cA, oA[1]);
    if (wr == 1) PG8_BAR;
    PG8_WAIT_V(2); PG8_BAR;
    PG8_STAGE(PG8_SB(1, 0), cB + kstep, voffB); PG8_STAGE(PG8_SA(1, 0), cA + kstep, oA[0]); PG8_STAGE(PG8_SB(1, 1), cB + hstepB + kstep, voffB);
    PG8_WAIT_V(6); PG8_BAR;
    for (;;) {
        const bool has_next = S.next(ui + 1, nxt);
        const char* nA = has_next ? ((const char*)g.A + (GATHER ? (size_t)0 : ((size_t)nxt.bt * g.sA * 2 + (size_t)nxt.pm * tstepA))) : cA;
        const char* nB = has_next ? (const char*)g.Bt + (size_t)nxt.bt * g.sB * 2 + (size_t)nxt.pn * tstepB : cB;
        if constexpr (GATHER) { if (has_next) { PG8_GOFF(oN, ui + 1); } else {
#pragma unroll
            for (int _h = 0; _h < 2; ++_h)
#pragma unroll
                for (int _i = 0; _i < 2; ++_i) oN[_h][_i] = oA[_h][_i]; } }
        for (int t = 0; t < nt; t += 2) {
            const bool last = (t == nt - 2);
            const char* a1 = cA + (size_t)(t + 1) * kstep;
            const char* a2 = last ? nA : cA + (size_t)(t + 2) * kstep; const char* b2 = last ? nB : cB + (size_t)(t + 2) * kstep;
            const char* a3 = a2 + kstep; const char* b3 = b2 + kstep;
            unsigned o2[2][2];
#pragma unroll
            for (int _h = 0; _h < 2; ++_h)
#pragma unroll
                for (int _i = 0; _i < 2; ++_i) o2[_h][_i] = (GATHER && last) ? oN[_h][_i] : oA[_h][_i];
            PG8_LDB(B0, 0, 0); PG8_LDB(B1, 0, 1); PG8_SCHED; PG8_LDA(At, 0, 0); PG8_STAGE(PG8_SA(1, 1), a1, oA[1]);
            PG8_WAIT_V(8); PG8_WAIT_L(0); PG8_BAR; PG8_MMA(0, 0, At, B0); PG8_MMA(0, 1, At, B1); PG8_BAR; PG8_SCHED;
            PG8_LDA(At, 0, 1); PG8_STAGE(PG8_SB(0, 0), b2, voffB); PG8_STAGE(PG8_SB(0, 1), b2 + hstepB, voffB); PG8_STAGE(PG8_SA(0, 0), a2, o2[0]);
            PG8_WAIT_V(8); PG8_WAIT_L(0); PG8_BAR; PG8_MMA(1, 0, At, B0); PG8_MMA(1, 1, At, B1); PG8_BAR; PG8_SCHED;
            PG8_LDB(B0, 1, 0); PG8_LDB(B1, 1, 1); PG8_SCHED; PG8_LDA(At, 1, 0); PG8_STAGE(PG8_SA(0, 1), a2, o2[1]);
            PG8_WAIT_V(8); PG8_WAIT_L(0); PG8_BAR; PG8_MMA(0, 0, At, B0); PG8_MMA(0, 1, At, B1); PG8_BAR; PG8_SCHED;
            PG8_LDA(At, 1, 1); PG8_STAGE(PG8_SB(1, 0), b3, voffB); PG8_STAGE(PG8_SB(1, 1), b3 + hstepB, voffB); PG8_STAGE(PG8_SA(1, 0), a3, o2[0]);
            PG8_WAIT_V(8); PG8_WAIT_L(0); PG8_BAR; PG8_MMA(1, 0, At, B0); PG8_MMA(1, 1, At, B1); PG8_BAR; PG8_SCHED;
        }
        if constexpr (ALIGN_EPI) { if (wr == 0) PG8_BAR; }
        E(acc, cur, wr, wc, fr, fq);
        if (!has_next) break;
#pragma unroll
        for (int a = 0; a < 2; ++a)
#pragma unroll
            for (int b = 0; b < 2; ++b)
#pragma unroll
                for (int m = 0; m < 4; ++m)
#pragma unroll
                    for (int n = 0; n < 2; ++n) acc[a][b][m][n] = (f32x4){0.f, 0.f, 0.f, 0.f};
        cur = nxt; cA = nA; cB = nB; ++ui;
        if constexpr (GATHER) {
#pragma unroll
            for (int _h = 0; _h < 2; ++_h)
#pragma unroll
                for (int _i = 0; _i < 2; ++_i) oA[_h][_i] = oN[_h][_i]; }
        if constexpr (ALIGN_EPI) { if (wr == 1) PG8_BAR; }
    }
    PG8_WAIT_V(0);
    if constexpr (!ALIGN_EPI) { if (wr == 0) PG8_BAR; }
    PG8_BAR;
#undef PG8_SA
#undef PG8_SB
#undef PG8_STAGE
#undef PG8_LDA
#undef PG8_LDB
#undef PG8_MMA
#undef PG8_WAIT_V
#undef PG8_WAIT_L
#undef PG8_BAR
#undef PG8_SCHED
#undef PG8_GOFF
}
}
namespace pg8 {
struct EpiBf16 {
    static constexpr bool PERM = true;
    bf16_t* O; int ldc; int nscale; float scale;
    __device__ __forceinline__ void operator()(const f32x4 (&acc)[2][2][4][2], const Unit& u, int wr, int wc, int fr, int fq) const {
        const int row0 = u.pm * BM + wr * 64 + fr, col0 = u.pn * BM + wc * 32 + 8 * fq; const float sc = (u.pn < nscale) ? scale : 1.f;
#pragma unroll
        for (int ai = 0; ai < 2; ++ai)
#pragma unroll
            for (int m = 0; m < 4; ++m) { bf16_t* rowp = O + (size_t)(row0 + ai * HALF + m * 16) * ldc + col0;
#pragma unroll
                for (int bj = 0; bj < 2; ++bj) { const f32x4 v0 = acc[ai][bj][m][0] * sc, v1 = acc[ai][bj][m][1] * sc;
                    u32x4 w; w.x = cvt_pk_bf16(v0[0], v0[1]); w.y = cvt_pk_bf16(v0[2], v0[3]); w.z = cvt_pk_bf16(v1[0], v1[1]); w.w = cvt_pk_bf16(v1[2], v1[3]);
                    *(u32x4*)(rowp + bj * HALF) = w; } }
    }
};
struct EpiSwiGLU {
    static constexpr bool PERM = true;
    bf16_t* O; int ldc;
    __device__ __forceinline__ void operator()(const f32x4 (&acc)[2][2][4][2], const Unit& u, int wr, int wc, int fr, int fq) const {
        const int row0 = u.pm * BM + wr * 64 + fr, col0 = u.pn * HALF + wc * 32 + 8 * fq;
#pragma unroll
        for (int ai = 0; ai < 2; ++ai)
#pragma unroll
            for (int m = 0; m < 4; ++m) { bf16_t* rowp = O + (size_t)(row0 + ai * HALF + m * 16) * ldc + col0;
                float r[8];
#pragma unroll
                for (int n = 0; n < 2; ++n)
#pragma unroll
                    for (int j = 0; j < 4; ++j) { const float gt = acc[ai][0][m][n][j], up = acc[ai][1][m][n][j]; r[n * 4 + j] = silu_f(gt) * up; }
                u32x4 w; w.x = cvt_pk_bf16(r[0], r[1]); w.y = cvt_pk_bf16(r[2], r[3]); w.z = cvt_pk_bf16(r[4], r[5]); w.w = cvt_pk_bf16(r[6], r[7]);
                *(u32x4*)rowp = w; }
    }
};
struct EpiResid {
    static constexpr bool PERM = false;
    const float* base; float* out; const float* gate;
    __device__ __forceinline__ void operator()(const f32x4 (&acc)[2][2][4][2], const Unit& u, int wr, int wc, int fr, int fq) const {
        const int row0 = u.pm * BM + wr * 64 + fr, col0 = u.pn * BM + wc * 32 + 4 * fq; const float* gv = gate + (size_t)(u.pm >> 4) * 3072;
#pragma unroll
        for (int bj = 0; bj < 2; ++bj)
#pragma unroll
            for (int n = 0; n < 2; ++n) { const int col = col0 + bj * HALF + n * 16; const f32x4 gg = *(const f32x4*)(gv + col);
#pragma unroll
                for (int ai = 0; ai < 2; ++ai)
#pragma unroll
                    for (int m = 0; m < 4; ++m) { const size_t off = (size_t)(row0 + ai * HALF + m * 16) * 1024 + col;
                        const f32x4 bs = *(const f32x4*)(base + off); *(f32x4*)(out + off) = bs + gg * acc[ai][bj][m][n]; } }
    }
};
struct EpiS5U {
    static constexpr bool PERM = true;
    bf16_t* AU;
    __device__ __forceinline__ void operator()(const f32x4 (&acc)[2][2][4][2], const Unit& u, int wr, int wc, int fr, int fq) const {
        const int row0 = u.pm * BM + wr * 64 + fr, col0 = u.pn * BM + wc * 32 + 8 * fq;
#pragma unroll
        for (int ai = 0; ai < 2; ++ai)
#pragma unroll
            for (int m = 0; m < 4; ++m) { const int tok = row0 + ai * HALF + m * 16;
#pragma unroll
                for (int bj = 0; bj < 2; ++bj) { const int c8 = col0 + bj * HALF, gi = c8 >> 4, k0 = c8 & 15; const f32x4 v0 = acc[ai][bj][m][0], v1 = acc[ai][bj][m][1];
                    u32x4 w; w.x = cvt_pk_bf16(v0[0], v0[1]); w.y = cvt_pk_bf16(v0[2], v0[3]); w.z = cvt_pk_bf16(v1[0], v1[1]); w.w = cvt_pk_bf16(v1[2], v1[3]);
                    *(u32x4*)(AU + ((size_t)(gi * 512 + (tok >> 5)) * 640 + (tok & 31) * 16 + k0)) = w; } }
    }
};
struct EpiS5E {
    static constexpr bool PERM = false;
    float* E;
    __device__ __forceinline__ void operator()(const f32x4 (&acc)[2][2][4][2], const Unit& u, int wr, int wc, int fr, int fq) const {
        const int row0 = u.pm * BM + wr * 64 + fr, col0 = wc * 32 + 4 * fq;
#pragma unroll
        for (int ai = 0; ai < 2; ++ai)
#pragma unroll
            for (int m = 0; m < 4; ++m)
#pragma unroll
                for (int n = 0; n < 2; ++n) *(f32x4*)(E + ((size_t)(u.bt * 512 + row0 + ai * HALF + m * 16) * 128 + col0 + n * 16)) = acc[ai][0][m][n];
    }
};
struct EpiS5Y {
    static constexpr bool PERM = true;
    const bf16_t* AU; const float* dskip; bf16_t* YG;
    __device__ __forceinline__ void operator()(const f32x4 (&acc)[2][2][4][2], const Unit& u, int wr, int wc, int fr, int fq) const {
        const int row0 = u.pm * BM + wr * 64 + fr, col0 = u.pn * BM + wc * 32 + 8 * fq;
#pragma unroll
        for (int bj = 0; bj < 2; ++bj) { const int c8 = col0 + bj * HALF, ii = c8 >> 4, k0 = c8 & 15, ch = u.bt * 16 + k0;
            const f32x4 d0 = *(const f32x4*)(dskip + ch), d1 = *(const f32x4*)(dskip + ch + 4);
#pragma unroll
            for (int ai = 0; ai < 2; ++ai)
#pragma unroll
                for (int m = 0; m < 4; ++m) { const int row = row0 + ai * HALF + m * 16;
                    const u32x4 uu = *(const u32x4*)(AU + ((size_t)(u.bt * 512 + row) * 640 + c8));
                    const f32x4 v0 = acc[ai][bj][m][0], v1 = acc[ai][bj][m][1];
                    float r[8];
                    r[0] = v0[0] + d0[0] * bf_lo(uu.x); r[1] = v0[1] + d0[1] * bf_hi(uu.x); r[2] = v0[2] + d0[2] * bf_lo(uu.y); r[3] = v0[3] + d0[3] * bf_hi(uu.y);
                    r[4] = v1[0] + d1[0] * bf_lo(uu.z); r[5] = v1[1] + d1[1] * bf_hi(uu.z); r[6] = v1[2] + d1[2] * bf_lo(uu.w); r[7] = v1[3] + d1[3] * bf_hi(uu.w);
#pragma unroll
                    for (int j = 0; j < 8; ++j) r[j] = gelu_tanh_f(r[j]);
                    u32x4 w; w.x = cvt_pk_bf16(r[0], r[1]); w.y = cvt_pk_bf16(r[2], r[3]); w.z = cvt_pk_bf16(r[4], r[5]); w.w = cvt_pk_bf16(r[6], r[7]);
                    *(u32x4*)(YG + ((size_t)(row * 32 + ii) * 1024 + ch)) = w; } }
    }
};
struct EpiGlu {
    static constexpr bool PERM = true;
    const bf16_t* YG; bf16_t* Z;
    __device__ __forceinline__ void operator()(const f32x4 (&acc)[2][2][4][2], const Unit& u, int wr, int wc, int fr, int fq) const {
        const int row0 = u.pm * BM + wr * 64 + fr, col0 = u.pn * BM + wc * 32 + 8 * fq;
#pragma unroll
        for (int ai = 0; ai < 2; ++ai)
#pragma unroll
            for (int m = 0; m < 4; ++m) { const size_t ro = (size_t)(row0 + ai * HALF + m * 16) * 1024 + col0;
#pragma unroll
                for (int bj = 0; bj < 2; ++bj) { const u32x4 yy = *(const u32x4*)(YG + ro + bj * HALF); const f32x4 v0 = acc[ai][bj][m][0], v1 = acc[ai][bj][m][1];
                    float r[8];
                    r[0] = bf_lo(yy.x) * fast_sigmoid(v0[0]); r[1] = bf_hi(yy.x) * fast_sigmoid(v0[1]); r[2] = bf_lo(yy.y) * fast_sigmoid(v0[2]); r[3] = bf_hi(yy.y) * fast_sigmoid(v0[3]);
                    r[4] = bf_lo(yy.z) * fast_sigmoid(v1[0]); r[5] = bf_hi(yy.z) * fast_sigmoid(v1[1]); r[6] = bf_lo(yy.w) * fast_sigmoid(v1[2]); r[7] = bf_hi(yy.w) * fast_sigmoid(v1[3]);
                    u32x4 w; w.x = cvt_pk_bf16(r[0], r[1]); w.y = cvt_pk_bf16(r[2], r[3]); w.z = cvt_pk_bf16(r[4], r[5]); w.w = cvt_pk_bf16(r[6], r[7]);
                    *(u32x4*)(Z + ro + bj * HALF) = w; } }
    }
};
}
namespace attn_body {
using bf16=__hip_bfloat16;
using bf16x8=__attribute__((ext_vector_type(8)))short;
using s16x4=__attribute__((ext_vector_type(4)))short;
using f32x16=__attribute__((ext_vector_type(16)))float;
using u32x4=__attribute__((ext_vector_type(4)))unsigned;
using f32x4v=__attribute__((ext_vector_type(4)))float;
constexpr int BATCH=4,NHEAD=8,SEQ=4096,D=64,PQ=3072,PO=1024;
constexpr int NW=8,QBLK=32,QB=QBLK*NW,KVBLK=64,NQB=SEQ/QB;
constexpr int ATTN_UNIT_ROWS=QB;
__device__ __forceinline__ int crow(int r,int hi){return (r&3)+8*(r>>2)+4*hi;}
#define SBAR() __builtin_amdgcn_sched_barrier(0)
__device__ __forceinline__ void cmask(f32x16&p0,f32x16&p1,int jb,int qrel,int hi){
  const float NEG=-INFINITY; int kb=64*jb+4*hi;
  #pragma unroll
  for(int r=0;r<16;++r){int kv=kb+(r&3)+8*(r>>2); if(kv>qrel)p0[r]=NEG; if(kv+32>qrel)p1[r]=NEG;}
}

constexpr int NSLOT=3, SLOTB=8192;
constexpr int LDS_K=0, LDS_V=NSLOT*SLOTB, LDS_WS=2*NSLOT*SLOTB, LDS_OST=LDS_WS+NW*64*4, LDS_CUM=LDS_OST+NW*4096, LDS_BYTES=LDS_CUM+SEQ*4;
constexpr float C2=0.125f*1.4426950408889634f;
__device__ __forceinline__ void glds16(const void*gsrc,unsigned lds_dst){unsigned keep;
  asm volatile("s_mov_b32 %0, m0\n\ts_mov_b32 m0, %2\n\ts_nop 0\n\tglobal_load_lds_dwordx4 %1, off\n\ts_mov_b32 m0, %0":"=&s"(keep):"v"(gsrc),"s"(lds_dst):"memory");}
__device__ __forceinline__ float max3f(float a,float b,float c){float r;asm("v_max3_f32 %0, %1, %2, %3":"=v"(r):"v"(a),"v"(b),"v"(c));return r;}
__device__ __forceinline__ float max2f(float a,float b){float r;asm("v_max_f32_e32 %0, %1, %2":"=v"(r):"v"(a),"v"(b));return r;}
__device__ __forceinline__ float fadd_s(float a,float b){float r;asm("v_add_f32_e32 %0, %1, %2":"=v"(r):"v"(a),"v"(b));return r;}
__device__ __forceinline__ float fsub_s(float a,float b){float r;asm("v_sub_f32_e32 %0, %1, %2":"=v"(r):"v"(a),"v"(b));return r;}
typedef float f32x2_t __attribute__((ext_vector_type(2))); typedef __bf16 bf16x2_t __attribute__((ext_vector_type(2)));
__device__ __forceinline__ unsigned cvtpk_s(float lo,float hi){f32x2_t v={lo,hi};bf16x2_t b=__builtin_convertvector(v,bf16x2_t);return __builtin_bit_cast(unsigned,b);}
#define WAIT_BAR(N) asm volatile("s_waitcnt vmcnt(" #N ") lgkmcnt(0)\n\ts_barrier":::"memory")

__device__ __forceinline__ void qkt(f32x16&p0,f32x16&p1,const char*Kslot,const bf16x8*qr,int r32,int hi){
  const char*kb=Kslot+hi*1024+r32*16;
  #pragma unroll
  for(int d0=0;d0<4;++d0){
    const bf16x8 b0=*reinterpret_cast<const bf16x8*>(kb+d0*2048);
    const bf16x8 b1=*reinterpret_cast<const bf16x8*>(kb+d0*2048+512);
    p0=__builtin_amdgcn_mfma_f32_32x32x16_bf16(b0,qr[d0],p0,0,0,0);p1=__builtin_amdgcn_mfma_f32_32x32x16_bf16(b1,qr[d0],p1,0,0,0);}
}
typedef __attribute__((address_space(3))) const char* lds_cptr;
typedef short v4i16_t __attribute__((ext_vector_type(4)));
__device__ __forceinline__ void kload8(bf16x8*kf,lds_cptr kp){
  kf[0]=*(const __attribute__((address_space(3))) bf16x8*)(kp);      kf[1]=*(const __attribute__((address_space(3))) bf16x8*)(kp+512);
  kf[2]=*(const __attribute__((address_space(3))) bf16x8*)(kp+2048); kf[3]=*(const __attribute__((address_space(3))) bf16x8*)(kp+2560);
  kf[4]=*(const __attribute__((address_space(3))) bf16x8*)(kp+4096); kf[5]=*(const __attribute__((address_space(3))) bf16x8*)(kp+4608);
  kf[6]=*(const __attribute__((address_space(3))) bf16x8*)(kp+6144); kf[7]=*(const __attribute__((address_space(3))) bf16x8*)(kp+6656);
}
__device__ __forceinline__ void kload2(bf16x8*kf,lds_cptr kp,int j){ kf[2*j]=*(const __attribute__((address_space(3))) bf16x8*)(kp+j*2048); kf[2*j+1]=*(const __attribute__((address_space(3))) bf16x8*)(kp+j*2048+512); }
__device__ __forceinline__ s16x4 vtr(lds_cptr p){ return __builtin_bit_cast(s16x4,__builtin_amdgcn_ds_read_tr16_b64_v4i16((__attribute__((address_space(3))) v4i16_t*)p)); }
__device__ __forceinline__ float rowmax(const f32x16&p0,const f32x16&p1){
  float a=max3f(p0[0],p0[1],p1[0]),b=max3f(p0[2],p0[3],p1[1]);a=max3f(a,p1[2],p1[3]);
  #pragma unroll
  for(int r=4;r<16;r+=4){a=max3f(a,p0[r],p0[r+1]);b=max3f(b,p0[r+2],p0[r+3]);a=max3f(a,p1[r],p1[r+1]);b=max3f(b,p1[r+2],p1[r+3]);}
  const float m=max2f(a,b);
  auto rr=__builtin_amdgcn_permlane32_swap(__float_as_uint(m),__float_as_uint(m),false,false);
  return max2f(__uint_as_float(rr[0]),__uint_as_float(rr[1]));
}
__device__ __forceinline__ void pv(f32x16*o,int vb,bf16x8 pa0,bf16x8 pa1,bf16x8 pa2,bf16x8 pa3){
  #pragma unroll
  for(int d0=0;d0<2;++d0){s16x4 lo[4],hi[4];
    #pragma unroll
    for(int ks=0;ks<4;++ks){
      asm volatile("ds_read_b64_tr_b16 %0,%1 offset:%c2":"=&v"(lo[ks]):"v"(vb),"i"(d0*4096+ks*1024):"memory");
      asm volatile("ds_read_b64_tr_b16 %0,%1 offset:%c2":"=&v"(hi[ks]):"v"(vb),"i"(d0*4096+ks*1024+512):"memory");}
    asm volatile("s_waitcnt lgkmcnt(0)":::"memory");SBAR();
    #define PK(k) (bf16x8){lo[k][0],lo[k][1],lo[k][2],lo[k][3],hi[k][0],hi[k][1],hi[k][2],hi[k][3]}
    o[d0]=__builtin_amdgcn_mfma_f32_32x32x16_bf16(pa0,PK(0),o[d0],0,0,0);
    o[d0]=__builtin_amdgcn_mfma_f32_32x32x16_bf16(pa1,PK(1),o[d0],0,0,0);
    o[d0]=__builtin_amdgcn_mfma_f32_32x32x16_bf16(pa2,PK(2),o[d0],0,0,0);
    o[d0]=__builtin_amdgcn_mfma_f32_32x32x16_bf16(pa3,PK(3),o[d0],0,0,0);
    #undef PK
  }
}

#ifndef ATTN_STORE16
#define ATTN_STORE16(p,v) (*(u32x4*)(p)=(v))
#endif
template<int THRL> __device__ __forceinline__ void attn_unit(int b,int h,int qb,const bf16*Q,const bf16*__restrict__ K,const bf16*__restrict__ V,bf16*O,const float*__restrict__ cumG,int t0,char*shm){
  const int tid=threadIdx.x,lane=tid&63,r32=lane&31,hi=lane>>5; const int wid=__builtin_amdgcn_readfirstlane(tid>>6);
  const long rowbase=(long)b*SEQ; const int q0=qb*QB;
  const bf16*Qw=Q+(rowbase+q0+wid*QBLK)*PQ+h*D;
  const bf16*Kh=K+(rowbase+(long)t0*KVBLK)*PQ+h*D,*Vh=V+(rowbase+(long)t0*KVBLK)*PQ+h*D;
  const unsigned lds0=(unsigned)(uintptr_t)shm;
  float*wsf=(float*)(shm+LDS_WS)+wid*64;
  const bf16*ksrc=Kh+(long)lane*PQ+wid*8;
  const bf16*vsrc=Vh+(long)(16*(wid&3)+(lane>>2))*PQ+(wid>>2)*32+(lane&3)*8;
  const unsigned kdst=lds0+LDS_K+wid*1024, vdst=lds0+LDS_V+wid*1024;
  #define DMA_K(t,slot) glds16(ksrc+(long)(t)*KVBLK*PQ,(unsigned)__builtin_amdgcn_readfirstlane(kdst+(slot)))
  #define DMA_V(t,slot) glds16(vsrc+(long)(t)*KVBLK*PQ,(unsigned)__builtin_amdgcn_readfirstlane(vdst+(slot)))
  const int vb0=(int)(lds0+LDS_V)+((lane>>4)&1)*32+(lane&3)*8+(4*hi+((lane&15)>>2))*64;
  const char*Kbase=shm+LDS_K; bf16x8 kf[8];
  const lds_cptr shm3=(lds_cptr)shm; const lds_cptr kp0=shm3+LDS_K+hi*1024+r32*16; const lds_cptr vp0=shm3+LDS_V+((lane>>4)&1)*32+(lane&3)*8+(4*hi+((lane&15)>>2))*64;
  const int NT=(q0+QB)/KVBLK-t0;
  typedef __attribute__((address_space(3))) float lds_f32; typedef __attribute__((address_space(3))) const f32x4v lds_cf4;
  { lds_f32*cl=(lds_f32*)(shm3+LDS_CUM)+tid; const float*cg_=cumG+tid; float cv_[8];
    _Pragma("unroll") for(int i=0;i<8;++i)cv_[i]=cg_[i*NW*64];
    _Pragma("unroll") for(int i=0;i<8;++i)cl[i*NW*64]=cv_[i]; }
  const lds_cptr cum3=shm3+LDS_CUM+16*hi+t0*256;
  DMA_K(0,0);DMA_V(0,0);DMA_K(1,SLOTB);
  bf16x8 qr[4];
  #pragma unroll
  for(int d0=0;d0<4;++d0)qr[d0]=*reinterpret_cast<const bf16x8*>(&Qw[(long)r32*PQ+d0*16+hi*8]);
  float mhat=0.f,l_reg=0.f,qm=0.f;f32x16 o[2];o[0]=f32x16{};o[1]=f32x16{};
  const int qrel=wid*QBLK+r32;
  #define CMASK(P0,P1,t) do{int jb_=(t)-(NT-4); if(jb_>=0)cmask(P0,P1,jb_,qrel,hi);}while(0)
  bool resc=false;
  #define START(P0,P1) do{ const float rm=rowmax(P0,P1); resc=false; \
    if(__any(rm>(float)THRL)){ const float dl=__builtin_fmaxf(rm,0.f); mhat+=dl; qm-=dl; \
      _Pragma("unroll") for(int r=0;r<16;++r){P0[r]-=dl;P1[r]-=dl;} } \
    _Pragma("unroll") for(int r=0;r<16;++r)P0[r]=__builtin_amdgcn_exp2f(P0[r]); }while(0)
  #define BIAS(P0,P1,t) do{ const lds_cptr cb_=cum3+(t)*256; \
    _Pragma("unroll") for(int g_=0;g_<4;++g_){ const f32x4v c0_=*(lds_cf4*)(cb_+g_*32), c1_=*(lds_cf4*)(cb_+128+g_*32); \
      _Pragma("unroll") for(int i_=0;i_<4;++i_){ P0[4*g_+i_]=qm-c0_[i_]; P1[4*g_+i_]=qm-c1_[i_]; } } }while(0)
  #define RESC() do{ if(resc){ asm volatile("s_waitcnt lgkmcnt(0)":::"memory"); \
      _Pragma("unroll") for(int d_=0;d_<2;++d_) _Pragma("unroll") for(int r=0;r<16;++r)o[d_][r]*=wsf[crow(r,hi)]; } }while(0)
  f32x16 pA0,pA1,pB0,pB1;
  int sl_prev=0,sl_cur=0,sl_next=SLOTB;
  #define ROT() do{sl_prev=sl_cur;sl_cur=sl_next;sl_next=(sl_next==(NSLOT-1)*SLOTB)?0:sl_next+SLOTB;}while(0)
  DMA_K(2,2*SLOTB);
  WAIT_BAR(3);
  qm=*(const __attribute__((address_space(3))) float*)(shm3+LDS_CUM+(q0+qrel)*4);
  BIAS(pA0,pA1,0);
  qkt(pA0,pA1,Kbase,qr,r32,hi);asm volatile("s_nop 15\n\ts_nop 7":"+v"(pA0),"+v"(pA1));CMASK(pA0,pA1,0);
  START(pA0,pA1);
  _Pragma("unroll") for(int r=0;r<16;++r)pA1[r]=__builtin_amdgcn_exp2f(pA1[r]);
  WAIT_BAR(0);
  DMA_K(3,0);DMA_V(1,SLOTB);
  ROT();
  kload8(kf,kp0+sl_cur);
  BIAS(pB0,pB1,1);
  WAIT_BAR(2);
  s16x4 vlo[8],vhi[8]; u32x4 pw0,pw1,pw2,pw3;
  #define PKW(P,B) cvtpk_s(P[B],P[B+1])
  #define PAF(k) __builtin_bit_cast(bf16x8,pw##k)
  #define VFR(i) (bf16x8){vlo[i][0],vlo[i][1],vlo[i][2],vlo[i][3],vhi[i][0],vhi[i][1],vhi[i][2],vhi[i][3]}
  #define PIN(x) asm volatile("":"+v"(x))
  #define MX3(a,b,c) __builtin_fmaxf(__builtin_fmaxf((a),(b)),(c))
  #define GAPA(MF,A0,A1,A2,A3,W0,W1,PW) do{ MF; sacc+=A0; sacc+=A1; sacc+=A2; sacc+=A3; PIN(sacc); W0; W1; PIN(PW); SBAR(); }while(0)
  #define EX(v) __builtin_amdgcn_exp2f(v)
  #define GAPB(MF,X,B,EXTRA) do{ MF; X[B]=EX(X[B]); X[B+1]=EX(X[B+1]); X[B+2]=EX(X[B+2]); X[B+3]=EX(X[B+3]); PIN(X); EXTRA; SBAR(); }while(0)
  #define BRD(g) (*(lds_cf4*)(cbn_+((g)&3)*32+((g)>>2)*128))
  #define BCP(X,B,c) do{ X[B]=qm-c[0]; X[B+1]=qm-c[1]; X[B+2]=qm-c[2]; X[B+3]=qm-c[3]; PIN(X); }while(0)
  #define VRD(i) do{ vlo[i]=vtr(vp_+(((i)>>2)*4096+((i)&3)*1024)); vhi[i]=vtr(vp_+(((i)>>2)*4096+((i)&3)*1024+512)); }while(0)
  #define KRD(G,j) do{ if(G){ kload2(kf,kp0+sl_next,j); SBAR(); } }while(0)
  #define STEP(C0,C1,P0,P1,t,GK,GV,GL) do{ SBAR(); \
    const lds_cptr vp_=vp0+sl_prev; \
    VRD(0); SBAR(); float sacc=(P0[0]+P0[1]); \
    GAPA(C0=__builtin_amdgcn_mfma_f32_32x32x16_bf16(kf[0],qr[0],C0,0,0,0), P0[2],P0[3],P0[4],P0[5],     pw0[0]=PKW(P0,0), pw0[1]=PKW(P0,2), pw0); \
    VRD(4); SBAR(); GAPA(C1=__builtin_amdgcn_mfma_f32_32x32x16_bf16(kf[1],qr[0],C1,0,0,0), P0[6],P0[7],P0[8],P0[9],     pw0[2]=PKW(P0,4), pw0[3]=PKW(P0,6), pw0); \
    VRD(1); SBAR(); GAPA(C0=__builtin_amdgcn_mfma_f32_32x32x16_bf16(kf[2],qr[1],C0,0,0,0),   P0[10],P0[11],P0[12],P0[13], pw1[0]=PKW(P0,8), pw1[1]=PKW(P0,10), pw1); \
    VRD(5); SBAR(); GAPA(C1=__builtin_amdgcn_mfma_f32_32x32x16_bf16(kf[3],qr[1],C1,0,0,0),   P0[14],P0[15],P1[0],P1[1],   pw1[2]=PKW(P0,12),pw1[3]=PKW(P0,14), pw1); \
    VRD(2); SBAR(); GAPA(C0=__builtin_amdgcn_mfma_f32_32x32x16_bf16(kf[4],qr[2],C0,0,0,0),   P1[2],P1[3],P1[4],P1[5],     pw2[0]=PKW(P1,0), pw2[1]=PKW(P1,2), pw2); \
    VRD(6); SBAR(); GAPA(C1=__builtin_amdgcn_mfma_f32_32x32x16_bf16(kf[5],qr[2],C1,0,0,0),   P1[6],P1[7],P1[8],P1[9],     pw2[2]=PKW(P1,4), pw2[3]=PKW(P1,6), pw2); \
    VRD(3); SBAR(); GAPA(C0=__builtin_amdgcn_mfma_f32_32x32x16_bf16(kf[6],qr[3],C0,0,0,0),   P1[10],P1[11],P1[12],P1[13], pw3[0]=PKW(P1,8), pw3[1]=PKW(P1,10), pw3); \
    VRD(7); SBAR(); GAPA(C1=__builtin_amdgcn_mfma_f32_32x32x16_bf16(kf[7],qr[3],C1,0,0,0),   P1[14],P1[15],0.f,0.f,       pw3[2]=PKW(P1,12),pw3[3]=PKW(P1,14), pw3); \
    l_reg+=sacc; \
    if(GK){DMA_K((t)+3,sl_cur);} if(GV){DMA_V((t)+1,sl_next);} \
    CMASK(C0,C1,t); \
    { float a=MX3(C0[0],C0[1],C1[0]),b=MX3(C0[2],C0[3],C1[1]); a=MX3(a,C1[2],C1[3]); \
      _Pragma("unroll") for(int r=4;r<16;r+=4){a=MX3(a,C0[r],C0[r+1]);b=MX3(b,C0[r+2],C0[r+3]);a=MX3(a,C1[r],C1[r+1]);b=MX3(b,C1[r+2],C1[r+3]);} \
      float rm=__builtin_fmaxf(a,b); { auto rr=__builtin_amdgcn_permlane32_swap(__float_as_uint(rm),__float_as_uint(rm),false,false); rm=__builtin_fmaxf(__uint_as_float(rr[0]),__uint_as_float(rr[1])); } \
      resc=false; \
      if(__builtin_expect(__any(rm>(float)THRL),0)){ const float dl=__builtin_fmaxf(rm,0.f); mhat+=dl; \
        _Pragma("unroll") for(int r=0;r<16;++r){C0[r]-=dl;C1[r]-=dl;} \
        qm-=dl; \
        const float f=__builtin_amdgcn_exp2f(-dl); l_reg*=f; if(hi==0)wsf[r32]=f; resc=true; } } \
    const lds_cptr cbn_=cum3+((t)+1)*256; f32x4v ca_; if(GL){ca_=BRD(0);} \
    SBAR(); \
    GAPB(o[0]=__builtin_amdgcn_mfma_f32_32x32x16_bf16(PAF(0),VFR(0),o[0],0,0,0), C0,0, if(GL){BCP(P0,0,ca_);ca_=BRD(1);}); \
    GAPB(o[1]=__builtin_amdgcn_mfma_f32_32x32x16_bf16(PAF(0),VFR(4),o[1],0,0,0), C0,4, if(GL){BCP(P0,4,ca_);ca_=BRD(2);}); \
    KRD(GL,0); GAPB(o[0]=__builtin_amdgcn_mfma_f32_32x32x16_bf16(PAF(1),VFR(1),o[0],0,0,0), C0,8, if(GL){BCP(P0,8,ca_);ca_=BRD(3);}); \
    KRD(GL,1); GAPB(o[1]=__builtin_amdgcn_mfma_f32_32x32x16_bf16(PAF(1),VFR(5),o[1],0,0,0), C0,12, if(GL){BCP(P0,12,ca_);ca_=BRD(4);}); \
    KRD(GL,2); GAPB(o[0]=__builtin_amdgcn_mfma_f32_32x32x16_bf16(PAF(2),VFR(2),o[0],0,0,0), C1,0, if(GL){BCP(P1,0,ca_);ca_=BRD(5);}); \
    KRD(GL,3); GAPB(o[1]=__builtin_amdgcn_mfma_f32_32x32x16_bf16(PAF(2),VFR(6),o[1],0,0,0), C1,4, if(GL){BCP(P1,4,ca_);ca_=BRD(6);}); \
    GAPB(o[0]=__builtin_amdgcn_mfma_f32_32x32x16_bf16(PAF(3),VFR(3),o[0],0,0,0), C1,8, if(GL){BCP(P1,8,ca_);ca_=BRD(7);}); \
    GAPB(o[1]=__builtin_amdgcn_mfma_f32_32x32x16_bf16(PAF(3),VFR(7),o[1],0,0,0), C1,12, if(GL){BCP(P1,12,ca_);}); \
    }while(0)
  int t=1;
  #undef CMASK
  #define CMASK(P0,P1,t) do{}while(0)
  for(;t+5<NT;t+=2){
    STEP(pB0,pB1,pA0,pA1,t,true,true,true);     WAIT_BAR(2); RESC(); ROT();
    STEP(pA0,pA1,pB0,pB1,t+1,true,true,true);   WAIT_BAR(2); RESC(); ROT();
  }
  #undef CMASK
  #define CMASK(P0,P1,t) do{int jb_=(t)-(NT-4); if(jb_>=0)cmask(P0,P1,jb_,qrel,hi);}while(0)
  #define ENDW(tt) do{ if((tt)+3<NT){WAIT_BAR(2);} else if((tt)+2<NT){WAIT_BAR(1);} else {WAIT_BAR(0);} }while(0)
  for(;t+1<NT;t+=2){
    STEP(pB0,pB1,pA0,pA1,t,(t+3<NT),(t+1<NT),(t+1<NT));       ENDW(t);   RESC(); ROT();
    STEP(pA0,pA1,pB0,pB1,t+1,(t+4<NT),(t+2<NT),(t+2<NT));     ENDW(t+1); RESC(); ROT();
  }
  STEP(pB0,pB1,pA0,pA1,NT-1,false,false,false); RESC();
  { float sacc=pB0[0]+pB0[1]; _Pragma("unroll") for(int r=2;r<16;++r)sacc+=pB0[r]; _Pragma("unroll") for(int r=0;r<16;++r)sacc+=pB1[r]; l_reg+=sacc;
    pw0=(u32x4){PKW(pB0,0),PKW(pB0,2),PKW(pB0,4),PKW(pB0,6)};pw1=(u32x4){PKW(pB0,8),PKW(pB0,10),PKW(pB0,12),PKW(pB0,14)};pw2=(u32x4){PKW(pB1,0),PKW(pB1,2),PKW(pB1,4),PKW(pB1,6)};pw3=(u32x4){PKW(pB1,8),PKW(pB1,10),PKW(pB1,12),PKW(pB1,14)};
    SBAR(); pv(o,vb0+sl_cur,PAF(0),PAF(1),PAF(2),PAF(3)); }
  #undef PKW
  #undef PAF
  #undef VFR
  #undef PIN
  #undef MX3
  #undef GAPA
  #undef GAPB
  #undef BRD
  #undef BCP
  #undef BIAS
  #undef EX
  #undef VRD
  #undef KRD
  #undef STEP
  #undef ENDW
  {auto rr=__builtin_amdgcn_permlane32_swap(__float_as_uint(l_reg),__float_as_uint(l_reg),false,false);l_reg=__uint_as_float(rr[0])+__uint_as_float(rr[1]);}
  if(hi==0)wsf[32+r32]=l_reg;asm volatile("s_waitcnt lgkmcnt(0)":::"memory");
  float rli[16];
  #pragma unroll
  for(int r=0;r<16;++r)rli[r]=__builtin_amdgcn_rcpf(wsf[32+crow(r,hi)]);
  bf16*Ow=O+(rowbase+q0+wid*QBLK)*PO+h*D;
  { bf16*stg=(bf16*)(shm+LDS_OST)+wid*2048;
    #pragma unroll
    for(int r=0;r<16;++r){const int orow=crow(r,hi);
      #pragma unroll
      for(int d0=0;d0<2;++d0)stg[orow*64+d0*32+r32]=__float2bfloat16(o[d0][r]*rli[r]);}
    asm volatile("s_waitcnt lgkmcnt(0)":::"memory");
    #pragma unroll
    for(int i=0;i<4;++i){const int row=i*8+(lane>>3),ch=lane&7; const u32x4 v=*(const u32x4*)(stg+row*64+ch*8); ATTN_STORE16(Ow+(long)row*PO+ch*8,v);} }
  asm volatile("s_waitcnt lgkmcnt(0)\n\ts_barrier":::"memory");
  #undef DMA_K
  #undef DMA_V
  #undef CMASK
  #undef START
  #undef RESC
  #undef ROT
}
constexpr int ATTN_LDS_BYTES=LDS_BYTES+16;
struct AttnTensors { const bf16* Q; const bf16* K; const bf16* V; bf16* O; const float* cum; const unsigned* qk2; unsigned* queue; };
template<int THRL=8> __device__ __forceinline__ void attn_phase(char*lds,const AttnTensors&T){
  const int tid=threadIdx.x; __attribute__((address_space(3))) unsigned* qw=(__attribute__((address_space(3))) unsigned*)((__attribute__((address_space(3))) char*)lds+LDS_BYTES);
  for(;;){
    if(tid==0){ qw[0]=__hip_atomic_fetch_add(T.queue,1u,__ATOMIC_RELAXED,__HIP_MEMORY_SCOPE_AGENT); }
    __syncthreads();
    const int u=__builtin_amdgcn_readfirstlane((int)qw[0]);
    if(u>=BATCH*NHEAD*NQB)break;
    const int bh=u&(BATCH*NHEAD-1), qb=NQB-1-(u>>5), q0=qb*QB; const float*cumG=T.cum+(long)bh*SEQ;
    const float qn=__uint_as_float(T.qk2[2*bh]), kn=__uint_as_float(T.qk2[2*bh+1]); const float th=-(2.f*sqrtf(qn*kn)+40.f);
    const int lane=tid&63; const bool ok=(lane<4*qb)&&(cumG[q0]-cumG[64*lane+63]>=th);
    const unsigned long long mk=__ballot(ok); int t0=mk?(int)__builtin_ctzll(mk):4*qb; t0&=~1; t0=__builtin_amdgcn_readfirstlane(t0);
    attn_unit<THRL>(bh/NHEAD,bh%NHEAD,qb,T.Q,T.K,T.V,T.O,cumG,t0,lds);
  }
}
#undef SBAR
#undef WAIT_BAR
}
constexpr int NWAVES = 8, NTHR = 512;
constexpr int BATCH = 4, SEQ = 4096, DMODEL = 1024, MTOK = BATCH * SEQ;
constexpr int NQKV = 3072, INCOLS = 3096, DFF = 2816, NEXP = 8;
constexpr float EPS = 1e-6f, LOG2E = 1.4426950408889634f;
constexpr size_t MiB = 1u << 20;
constexpr size_t WS_CTL = 0, CTL_ZERO_BYTES = 1 * MiB;
constexpr size_t WS_MOD = 1 * MiB;
constexpr size_t WS_WSK = WS_MOD + 256 * 1024;
constexpr size_t WS_AL = WS_WSK + 128 * 1024;
constexpr size_t WS_ROUTE = 2 * MiB;
constexpr size_t WS_ROWTOK = 3 * MiB;
constexpr size_t WS_CUM = 4 * MiB;
constexpr size_t WS_FFGLR = 5 * MiB;
constexpr size_t WS_GLAEB = 7 * MiB;
constexpr size_t WS_WIN0 = 8 * MiB, WS_WO0 = 14 * MiB, WS_WGU0 = 16 * MiB, WS_WD0 = 27 * MiB;
constexpr size_t WS_WIN1 = 33 * MiB, WS_WGLU = 35 * MiB, WS_WO1 = 37 * MiB, WS_S5T = 39 * MiB, WS_S5WA = 79 * MiB;
constexpr size_t WS_H3 = 8 * MiB;
constexpr size_t WS_WEGU = 95 * MiB, WS_WED = 183 * MiB;
constexpr size_t WS_YPERM = 95 * MiB;
constexpr size_t WS_BIG = 227 * MiB;
constexpr size_t WS_QKV = WS_BIG, WS_MIX = WS_BIG + 96 * MiB, WS_H = WS_BIG + 128 * MiB;
constexpr size_t WS_GLAB = WS_BIG + 160 * MiB;
constexpr size_t WS_ACT = WS_BIG;
constexpr size_t WS_AU = WS_BIG, WS_E = WS_BIG + 40 * MiB, WS_YG = WS_BIG + 56 * MiB, WS_Z = WS_BIG + 88 * MiB;
constexpr size_t WS_ACTP = WS_BIG;
constexpr size_t WS_END = 414 * MiB;
constexpr int MAXPROWS = 34816;
constexpr int CW_TMO = 0, CW_CODE = 1, CW_BAR = 4096, CW_ECNT = 8192;
constexpr int CW_AQ = 9216, CW_QK2 = 9280;
constexpr int RING_BYTES = 131072, GTAB_OFF = RING_BYTES, GTAB_BYTES = 16384, MISC_OFF = GTAB_OFF + GTAB_BYTES, LDS_BYTES = MISC_OFF + 1024;

typedef GAS unsigned gu32;
#define RLX_AGENT __ATOMIC_RELAXED, __HIP_MEMORY_SCOPE_AGENT
#define LDS_WAIT() asm volatile("s_waitcnt lgkmcnt(0)" ::: "memory")
#define VM_WAIT() asm volatile("s_waitcnt vmcnt(0)" ::: "memory")

#define XB_TMO      128
#define XB_XCNT(j)  (256  + 64 * (j))
#define XB_XSUB(j)  (1280 + 64 * (j))
#define XB_XGEN(j)  (2304 + 64 * (j))
#define XB_TOP      3328
#define XB_TOPGEN   3392
#define XCD_BAR_WORDS 3456
#define XB_SPIN_CAP (1u << 18)
__device__ __forceinline__ unsigned xb_ld(unsigned* p)              { return __hip_atomic_load(p, __ATOMIC_RELAXED, __HIP_MEMORY_SCOPE_AGENT); }
__device__ __forceinline__ unsigned xb_add(unsigned* p, unsigned v) { return __hip_atomic_fetch_add(p, v, __ATOMIC_RELAXED, __HIP_MEMORY_SCOPE_AGENT); }
__device__ __forceinline__ unsigned xb_xcc_id() { return (unsigned)__builtin_amdgcn_s_getreg((3 << 11) | 20) & 0xFu; }
#define XB_SPIN(cond, bar) do { unsigned _sp = 0; while (cond) { __builtin_amdgcn_s_sleep(1); \
    if ((++_sp & 255u) == 0u) { if (xb_ld(&(bar)[XB_TMO])) break; if (_sp > XB_SPIN_CAP) { atomicAdd(&(bar)[XB_TMO], 1u); break; } } } } while (0)
struct XcdBarrier { unsigned* bar; unsigned x; volatile LAS unsigned* st; };
__device__ __forceinline__ XcdBarrier xcd_barrier_post(unsigned* bar, volatile LAS unsigned* st) {
    XcdBarrier b; b.bar = bar; b.x = xb_xcc_id(); b.st = st;
    if (threadIdx.x == 0) (void)xb_add(&bar[XB_XCNT(b.x)], 1u);
    return b;
}
__device__ __forceinline__ void xcd_barrier_complete(unsigned* bar, unsigned x, unsigned& nloc, unsigned& nx) {
    const unsigned G = gridDim.x * gridDim.y * gridDim.z;
    unsigned sum, cnt, mine, sp = 0u;
    for (;;) {
        sum = 0u; cnt = 0u; mine = 0u;
#pragma unroll
        for (unsigned j = 0; j < 16; ++j) { const unsigned c = xb_ld(&bar[XB_XCNT(j)]); sum += c; cnt += (c > 0u) ? 1u : 0u; mine = (j == x) ? c : mine; }
        if (sum == G) break;
        __builtin_amdgcn_s_sleep(1);
        if ((++sp & 255u) == 0u) { if (xb_ld(&bar[XB_TMO])) break; if (sp > XB_SPIN_CAP) { atomicAdd(&bar[XB_TMO], 1u); break; } }
    }
    nloc = mine > 0u ? mine : 1u; nx = cnt > 0u ? cnt : 1u;
}
__device__ __forceinline__ void xcd_barrier(const XcdBarrier& b) {
    asm volatile("s_waitcnt vmcnt(0)" ::: "memory");
    __syncthreads();
    if (threadIdx.x == 0) {
        unsigned* bar = b.bar;
        __builtin_amdgcn_s_waitcnt(0);
        unsigned nloc = b.st[0], nx = b.st[1];
        if (nloc == 0u) { xcd_barrier_complete(bar, b.x, nloc, nx); b.st[0] = nloc; b.st[1] = nx; }
        const unsigned old = xb_add(&bar[XB_XSUB(b.x)], 1u);
        const unsigned gen = old / nloc;
        if (old + 1u == (gen + 1u) * nloc) {
            __builtin_amdgcn_fence(__ATOMIC_RELEASE, "agent");
            asm volatile("s_waitcnt vmcnt(0)" ::: "memory");
            const unsigned og = xb_add(&bar[XB_TOP], 1u);
            const unsigned tg = og / nx;
            if (og + 1u == (tg + 1u) * nx) xb_add(&bar[XB_TOPGEN], 1u);
            else XB_SPIN(xb_ld(&bar[XB_TOPGEN]) == tg, bar);
            __builtin_amdgcn_fence(__ATOMIC_ACQUIRE, "agent");
            xb_add(&bar[XB_XGEN(b.x)], 1u);
            asm volatile("s_waitcnt vmcnt(0)" ::: "memory");
        } else {
            XB_SPIN(xb_ld(&bar[XB_XGEN(b.x)]) == gen, bar);
            __builtin_amdgcn_fence(__ATOMIC_ACQUIRE, "agent");
            asm volatile("s_waitcnt vmcnt(0)" ::: "memory");
        }
    }
    __syncthreads();
}

struct Frame {
    LAS unsigned char* lds;
    gu32* ctl;
    int tid, lane, wave, vcu, G;
    const float* const* in; float* out; unsigned char* ws;
};
__device__ __forceinline__ float wave_sum(float v) {
#pragma unroll
    for (int o = 1; o < 64; o <<= 1) v += __shfl_xor(v, o);
    return v;
}
__device__ __forceinline__ unsigned f2bf(float f) { unsigned u = __builtin_bit_cast(unsigned, f); return (u + 0x7fffu + ((u >> 16) & 1u)) >> 16; }
__device__ __forceinline__ unsigned pk2(float lo, float hi) { return f2bf(lo) | (f2bf(hi) << 16); }
__device__ __forceinline__ float log_sigmoid_f(float x) { return fminf(x, 0.f) - log1pf(expf(-fabsf(x))); }
struct TrDesc { const float* src; bf16_t* dst; int ldw, K; };
__device__ __forceinline__ void tr_seg(const float* W, int ldw, int col0, int ncols, int K, bf16_t* WT, int mode, int rowoff, int item, int lane, TrDesc& D) {
    const int nblk = ncols >> 6, kb = item / nblk, nb = item - kb * nblk, n0 = nb * 64;
    const int drow = mode ? (((n0 >> 7) << 8) + (n0 & 127) + rowoff) : (rowoff + n0);
    D.src = W + (size_t)(kb * 64 + (lane >> 4)) * ldw + col0 + n0 + (lane & 15) * 4; D.dst = WT + (size_t)drow * K + kb * 64; D.ldw = ldw; D.K = K;
}
constexpr int TR_I_WIN = 384, TR_I_SQ = 256, TR_I_FF = 704;
constexpr int TR_NITEMS = 2 * TR_I_WIN + TR_I_SQ + 3 * TR_I_FF + 3 * TR_I_SQ + 24 * TR_I_FF;
__device__ __forceinline__ void tr_decode(Frame& F, int it, TrDesc& D) {
    unsigned char* ws = F.ws; const int lane = F.lane; int r = it;
    if (r < TR_I_WIN) { tr_seg(F.in[5], INCOLS, 0, 1536, 1024, (bf16_t*)(ws + WS_WIN0), 0, 0, r, lane, D); return; } r -= TR_I_WIN;
    if (r < TR_I_WIN) { tr_seg(F.in[5], INCOLS, 1544, 1536, 1024, (bf16_t*)(ws + WS_WIN0), 0, 1536, r, lane, D); return; } r -= TR_I_WIN;
    if (r < TR_I_SQ) { tr_seg(F.in[10], 1024, 0, 1024, 1024, (bf16_t*)(ws + WS_WO0), 0, 0, r, lane, D); return; } r -= TR_I_SQ;
    if (r < TR_I_FF) { tr_seg(F.in[14], DFF, 0, DFF, 1024, (bf16_t*)(ws + WS_WGU0), 1, 0, r, lane, D); return; } r -= TR_I_FF;
    if (r < TR_I_FF) { tr_seg(F.in[15], DFF, 0, DFF, 1024, (bf16_t*)(ws + WS_WGU0), 1, 128, r, lane, D); return; } r -= TR_I_FF;
    if (r < TR_I_FF) { tr_seg(F.in[16], 1024, 0, 1024, DFF, (bf16_t*)(ws + WS_WD0), 0, 0, r, lane, D); return; } r -= TR_I_FF;
    if (r < TR_I_SQ) { tr_seg(F.in[20], 1024, 0, 1024, 1024, (bf16_t*)(ws + WS_WIN1), 0, 0, r, lane, D); return; } r -= TR_I_SQ;
    if (r < TR_I_SQ) { tr_seg(F.in[29], 1024, 0, 1024, 1024, (bf16_t*)(ws + WS_WGLU), 0, 0, r, lane, D); return; } r -= TR_I_SQ;
    if (r < TR_I_SQ) { tr_seg(F.in[30], 1024, 0, 1024, 1024, (bf16_t*)(ws + WS_WO1), 0, 0, r, lane, D); return; } r -= TR_I_SQ;
    const int idx = r / TR_I_FF, ri = r - idx * TR_I_FF, e = idx / 3, kind = idx - e * 3;
    if (kind == 0) tr_seg(F.in[35] + (size_t)e * 1024 * DFF, DFF, 0, DFF, 1024, (bf16_t*)(ws + WS_WEGU) + (size_t)e * 5632 * 1024, 1, 0, ri, lane, D);
    else if (kind == 1) tr_seg(F.in[36] + (size_t)e * 1024 * DFF, DFF, 0, DFF, 1024, (bf16_t*)(ws + WS_WEGU) + (size_t)e * 5632 * 1024, 1, 128, ri, lane, D);
    else tr_seg(F.in[37] + (size_t)e * DFF * 1024, 1024, 0, 1024, DFF, (bf16_t*)(ws + WS_WED) + (size_t)e * 1024 * DFF, 0, 0, ri, lane, D);
}
__device__ __forceinline__ void tr_load(const TrDesc& D, f32x4 (&v)[16]) {
#pragma unroll
    for (int i = 0; i < 16; ++i) v[i] = __builtin_nontemporal_load((const f32x4*)(D.src + (size_t)(4 * i) * D.ldw));
}
__device__ __forceinline__ void tr_store(const TrDesc& D, const f32x4 (&v)[16], LAS float* scr, int lane) {
    const int rq = lane >> 4, c4 = (lane & 15) * 4;
#pragma unroll
    for (int i = 0; i < 16; ++i) { LAS float* d = scr + (4 * i + rq) * 65 + c4; d[0] = v[i].x; d[1] = v[i].y; d[2] = v[i].z; d[3] = v[i].w; }
    LDS_WAIT(); asm volatile("" ::: "memory");
    const int c = lane & 7;
#pragma unroll
    for (int j = 0; j < 8; ++j) { const int n = (lane >> 3) + 8 * j; const LAS float* s = scr + (8 * c) * 65 + n;
        u32x4 o; o.x = pk2(s[0 * 65], s[1 * 65]); o.y = pk2(s[2 * 65], s[3 * 65]); o.z = pk2(s[4 * 65], s[5 * 65]); o.w = pk2(s[6 * 65], s[7 * 65]);
        *(GAS u32x4*)(D.dst + (size_t)n * D.K + 8 * c) = o; }
    LDS_WAIT(); asm volatile("" ::: "memory");
}
__device__ __forceinline__ void p0_transposes(Frame& F) {
    LAS float* scr = (LAS float*)(F.lds + F.wave * 16896);
    const int gw = F.vcu * NWAVES + F.wave, NGW = F.G * NWAVES;
    int it = gw; if (it >= TR_NITEMS) return;
    TrDesc Da, Db; f32x4 va[16], vb[16];
    tr_decode(F, it, Da); tr_load(Da, va);
    for (;;) {
        int nx = it + NGW; const bool m1 = nx < TR_NITEMS;
        if (m1) { tr_decode(F, nx, Db); tr_load(Db, vb); }
        tr_store(Da, va, scr, F.lane);
        if (!m1) break;
        it = nx; nx = it + NGW; const bool m2 = nx < TR_NITEMS;
        if (m2) { tr_decode(F, nx, Da); tr_load(Da, va); }
        tr_store(Db, vb, scr, F.lane);
        if (!m2) break;
        it = nx;
    }
}
__device__ __forceinline__ void sincos_rev(double ang, float& cs, float& sn) {
    const double rev = ang * 0.15915494309189535; const float fr = (float)(rev - __builtin_rint(rev));
    cs = __builtin_amdgcn_cosf(fr); sn = __builtin_amdgcn_sinf(fr);
}
__device__ __forceinline__ void p0_mod_job(Frame& F, int job) {
    const int s = job / 48, cg = job - s * 48;
    const float* W = s == 0 ? F.in[3] : s == 1 ? F.in[12] : s == 2 ? F.in[18] : F.in[32]; const float* bias = s == 0 ? F.in[4] : s == 1 ? F.in[13] : s == 2 ? F.in[19] : F.in[33];
    LAS float* sc = (LAS float*)F.lds;
    LAS float* part = sc + 4096;
    for (int i = F.tid; i < 4096; i += NTHR) { const float v = F.in[1][i]; sc[i] = v / (1.f + expf(-v)); }
    __syncthreads();
    const int col = cg * 64 + F.lane; float a0 = 0.f, a1 = 0.f, a2 = 0.f, a3 = 0.f;
    const float* wp = W + (size_t)(F.wave * 128) * 3072 + col;
#pragma unroll 8
    for (int k = 0; k < 128; ++k) { const float w = wp[(size_t)k * 3072]; const int kk = F.wave * 128 + k;
        a0 += sc[kk] * w; a1 += sc[1024 + kk] * w; a2 += sc[2048 + kk] * w; a3 += sc[3072 + kk] * w; }
    part[(F.wave * 4 + 0) * 64 + F.lane] = a0; part[(F.wave * 4 + 1) * 64 + F.lane] = a1; part[(F.wave * 4 + 2) * 64 + F.lane] = a2; part[(F.wave * 4 + 3) * 64 + F.lane] = a3;
    __syncthreads();
    if (F.tid < 256) { const int b = F.tid >> 6, l = F.tid & 63; float t = bias[cg * 64 + l];
#pragma unroll
        for (int w = 0; w < 8; ++w) t += part[(w * 4 + b) * 64 + l];
        ((float*)(F.ws + WS_MOD))[(size_t)(s * 4 + b) * 3072 + cg * 64 + l] = t; }
    __syncthreads();
}
__device__ __forceinline__ void p0_s5_job(Frame& F, int job) {
    const int g = job >> 2, qd = job & 3, tid = F.tid;
    LAS float* L = (LAS float*)F.lds;
    LAS float* bbr = L;
    LAS float* bbi = L + 1024;
    LAS float* cr = L + 2048;
    LAS float* ci = L + 3072;
    LAS float* pwr = L + 4096;
    LAS float* pwi = pwr + 64 * 34;
    LAS float* Kt = pwi + 64 * 34;
    const float* lam_re = F.in[21] + g * 64; const float* lam_im = F.in[22] + g * 64; const float dt = expf(F.in[23][g]);
    const float* b_re = F.in[24] + (size_t)g * 1024; const float* b_im = F.in[25] + (size_t)g * 1024;
    const float* c_re = F.in[26] + (size_t)g * 1024; const float* c_im = F.in[27] + (size_t)g * 1024;
    for (int i = tid; i < 1024; i += NTHR) { cr[i] = c_re[i]; ci[i] = c_im[i]; }
    for (int i = tid; i < 64 * 33; i += NTHR) { const int p = i / 33, tau = i - p * 33; const float lr = lam_re[p], li = lam_im[p];
        const float mg = expf((float)tau * lr * dt); float cs, sn; sincos_rev((double)tau * (double)li * (double)dt, cs, sn); pwr[p * 34 + tau] = mg * cs; pwi[p * 34 + tau] = mg * sn; }
    for (int i = tid; i < 1024; i += NTHR) { const int p = i >> 4; const float lr = lam_re[p], li = lam_im[p];
        float cs, sn; sincos_rev((double)li * (double)dt, cs, sn);
        const float mg = expf(lr * dt), ar = mg * cs, ai = mg * sn, den = lr * lr + li * li, nr = ar - 1.f, ni = ai;
        const float fr = (nr * lr + ni * li) / den, fi = (ni * lr - nr * li) / den; const float br = b_re[i], bi = b_im[i];
        bbr[i] = fr * br - fi * bi; bbi[i] = fr * bi + fi * br; }
    __syncthreads();
    {
        const int tau = tid >> 4, k = tid & 15; float acc[16];
#pragma unroll
        for (int j = 0; j < 16; ++j) acc[j] = 0.f;
        for (int p = 0; p < 64; ++p) { const float c_r = cr[k * 64 + p], c_i = ci[k * 64 + p], w_r = pwr[p * 34 + tau], w_i = pwi[p * 34 + tau];
            const float m_r = c_r * w_r - c_i * w_i, m_i = c_r * w_i + c_i * w_r;
#pragma unroll
            for (int j = 0; j < 16; ++j) acc[j] += m_r * bbr[p * 16 + j] - m_i * bbi[p * 16 + j]; }
#pragma unroll
        for (int j = 0; j < 16; ++j) Kt[tau * 256 + k * 16 + j] = acc[j];
    }
    __syncthreads();
    bf16_t* T = (bf16_t*)(F.ws + WS_S5T) + (size_t)g * 512 * 640;
    for (int ch = tid; ch < 128 * 80; ch += NTHR) {
        const int rl = ch / 80, c8 = (ch - rl * 80) * 8, n = qd * 128 + rl, i = n >> 4, k = n & 15; float v[8];
        if (c8 < 512) { const int j = c8 >> 4, k0 = c8 & 15;
#pragma unroll
            for (int q = 0; q < 8; ++q) v[q] = (j <= i) ? Kt[(i - j) * 256 + k * 16 + k0 + q] : 0.f;
        } else { const int sidx = c8 - 512, im = sidx >> 6, p0 = sidx & 63;
#pragma unroll
            for (int q = 0; q < 8; ++q) { const int p = p0 + q; const float c_r = cr[k * 64 + p], c_i = ci[k * 64 + p], w_r = pwr[p * 34 + i + 1], w_i = pwi[p * 34 + i + 1];
                v[q] = im ? -(c_r * w_i + c_i * w_r) : (c_r * w_r - c_i * w_i); } }
        u32x4 o; o.x = pk2(v[0], v[1]); o.y = pk2(v[2], v[3]); o.z = pk2(v[4], v[5]); o.w = pk2(v[6], v[7]);
        *(GAS u32x4*)(T + (size_t)n * 640 + c8) = o; }
    bf16_t* WA = (bf16_t*)(F.ws + WS_S5WA) + (size_t)g * 256 * 512;
    for (int ch = tid; ch < 64 * 64; ch += NTHR) {
        const int rl = ch >> 6, c8 = (ch & 63) * 8, n = qd * 64 + rl, j = c8 >> 4, k0 = c8 & 15; float v[8];
        if (n < 128) { const int im = n >> 6, p = n & 63; const float w_r = pwr[p * 34 + 31 - j], w_i = pwi[p * 34 + 31 - j];
#pragma unroll
            for (int q = 0; q < 8; ++q) { const float b_r = bbr[p * 16 + k0 + q], b_i = bbi[p * 16 + k0 + q]; v[q] = im ? (w_r * b_i + w_i * b_r) : (w_r * b_r - w_i * b_i); }
        } else {
#pragma unroll
            for (int q = 0; q < 8; ++q) v[q] = 0.f; }
        u32x4 o; o.x = pk2(v[0], v[1]); o.y = pk2(v[2], v[3]); o.z = pk2(v[4], v[5]); o.w = pk2(v[6], v[7]);
        *(GAS u32x4*)(WA + (size_t)n * 512 + c8) = o; }
    if (qd == 0 && tid < 64) { float* al = (float*)(F.ws + WS_AL) + (size_t)(g * 64 + tid) * 2; al[0] = pwr[tid * 34 + 32]; al[1] = pwi[tid * 34 + 32]; }
    __syncthreads();
}
__device__ __forceinline__ void p0_prologue(Frame& F) {
    for (int job = blockIdx.x; job < 192; job += F.G) p0_mod_job(F, job);
    for (int job = blockIdx.x; job < 256; job += F.G) p0_s5_job(F, job);
    {
        float* wsk = (float*)(F.ws + WS_WSK);
        for (int i = blockIdx.x * NTHR + F.tid; i < 24 * 1024; i += F.G * NTHR) { const int c = i >> 10, k = i & 1023; wsk[i] = F.in[5][(size_t)k * INCOLS + (c < 8 ? 1536 + c : 3080 + c - 8)]; }
    }
    p0_transposes(F);
}
template <int MODE>
__device__ __forceinline__ void norm_mod_phase(Frame& F, const float* __restrict__ xsrc, const float* __restrict__ normw, const float* __restrict__ modv, bf16_t* __restrict__ hout) {
    LAS f32x2* tab = (LAS f32x2*)F.lds;
    LAS float* wx = (LAS float*)(F.lds + 32768);
    LAS int* wcnt = (LAS int*)(F.lds + 32768 + 98304);
    LAS int* wbase = wcnt + 64;
    for (int i = F.tid; i < 4096; i += NTHR) { const int b = i >> 10, c = i & 1023; tab[i] = (f32x2){normw[c] * (1.f + modv[b * 3072 + 1024 + c]), modv[b * 3072 + c]}; }
    if (MODE == 1) { const float* wsk = (const float*)(F.ws + WS_WSK); for (int i = F.tid; i < 24 * 1024; i += NTHR) wx[i] = wsk[i]; }
    if (MODE == 2) { const float* wr_ = F.in[34]; for (int i = F.tid; i < 8 * 1024; i += NTHR) { const int e = i >> 10, k = i & 1023; wx[i] = wr_[k * 8 + e]; } }
    __syncthreads();
    const int gw = F.vcu * NWAVES + F.wave, NGW = F.G * NWAVES, lane = F.lane;
    int cnt0 = 0, cnt1 = 0, cnt2 = 0, cnt3 = 0, cnt4 = 0, cnt5 = 0, cnt6 = 0, cnt7 = 0;
    unsigned* route = (unsigned*)(F.ws + WS_ROUTE);
    for (int m0 = gw; m0 < MTOK; m0 += 4 * NGW) {
        f32x4 v[4][4]; float rinv[4];
#pragma unroll
        for (int r = 0; r < 4; ++r) { const int m = m0 + r * NGW < MTOK ? m0 + r * NGW : m0; const GAS f32x4* xr = (const GAS f32x4*)(xsrc + (size_t)m * 1024) + lane;
#pragma unroll
            for (int j = 0; j < 4; ++j) v[r][j] = xr[64 * j]; }
#pragma unroll
        for (int r = 0; r < 4; ++r) { float ss = 0.f;
#pragma unroll
            for (int j = 0; j < 4; ++j) ss += (v[r][j].x * v[r][j].x + v[r][j].y * v[r][j].y) + (v[r][j].z * v[r][j].z + v[r][j].w * v[r][j].w);
            rinv[r] = 1.f / sqrtf(wave_sum(ss) * (1.f / 1024.f) + EPS); }
#pragma unroll
        for (int r = 0; r < 4; ++r) { const int m = m0 + r * NGW; const bool live = m < MTOK; const int b = (live ? m : m0) >> 12;
            GAS u32x2* o8 = (GAS u32x2*)(hout + (size_t)(live ? m : m0) * 1024) + lane;
#pragma unroll
            for (int j = 0; j < 4; ++j) { const int c = 4 * lane + 256 * j; const LAS f32x2* tb = tab + b * 1024 + c;
                const f32x2 t0 = tb[0], t1 = tb[1], t2 = tb[2], t3 = tb[3];
                v[r][j].x = v[r][j].x * rinv[r] * t0.x + t0.y; v[r][j].y = v[r][j].y * rinv[r] * t1.x + t1.y; v[r][j].z = v[r][j].z * rinv[r] * t2.x + t2.y; v[r][j].w = v[r][j].w * rinv[r] * t3.x + t3.y;
                if (live) o8[64 * j] = (u32x2){cvt_pk_bf16(v[r][j].x, v[r][j].y), cvt_pk_bf16(v[r][j].z, v[r][j].w)}; } }
        if (MODE == 1) {
            float a[96];
#pragma unroll
            for (int c = 0; c < 24; ++c) { f32x4 w[4];
#pragma unroll
                for (int j = 0; j < 4; ++j) w[j] = *(const LAS f32x4*)(wx + c * 1024 + 4 * lane + 256 * j);
#pragma unroll
                for (int r = 0; r < 4; ++r) { f32x2 p2 = {0.f, 0.f};
#pragma unroll
                    for (int j = 0; j < 4; ++j) { p2 = __builtin_elementwise_fma((f32x2){v[r][j].x, v[r][j].y}, (f32x2){w[j].x, w[j].y}, p2); p2 = __builtin_elementwise_fma((f32x2){v[r][j].z, v[r][j].w}, (f32x2){w[j].z, w[j].w}, p2); }
                    a[r * 24 + c] = p2.x + p2.y; } }
#define RS_STEP(MSK, HALF) { const bool hi_ = (lane & (MSK)) != 0; _Pragma("unroll") for (int i = 0; i < (HALF); ++i) { const float keep_ = hi_ ? a[i + (HALF)] : a[i], send_ = hi_ ? a[i] : a[i + (HALF)]; a[i] = keep_ + __shfl_xor(send_, (MSK)); } }
            RS_STEP(32, 48) RS_STEP(16, 24) RS_STEP(8, 12) RS_STEP(4, 6) RS_STEP(2, 3)
#undef RS_STEP
#pragma unroll
            for (int i = 0; i < 3; ++i) a[i] += __shfl_xor(a[i], 1);
            if ((lane & 1) == 0) { float* fg = (float*)(F.ws + WS_FFGLR);
#pragma unroll
                for (int i = 0; i < 3; ++i) { const int id = 3 * (lane >> 1) + i, r = id / 24, c = id - r * 24, m = m0 + r * NGW; if (m < MTOK) fg[(size_t)m * 24 + c] = a[i]; } }
        }
        if (MODE == 2) {
#pragma unroll
            for (int r = 0; r < 4; ++r) { const int m = m0 + r * NGW; if (m >= MTOK) continue;
                float lg[8];
#pragma unroll
                for (int e = 0; e < 8; ++e) { float p = 0.f;
#pragma unroll
                    for (int j = 0; j < 4; ++j) { const f32x4 w = *(const LAS f32x4*)(wx + e * 1024 + 4 * lane + 256 * j); p += (v[r][j].x * w.x + v[r][j].y * w.y) + (v[r][j].z * w.z + v[r][j].w * w.w); }
                    lg[e] = wave_sum(p); }
                int e0 = 0; float v0 = lg[0];
#pragma unroll
                for (int e = 1; e < 8; ++e) if (lg[e] > v0) { v0 = lg[e]; e0 = e; }
                int e1 = -1; float v1 = -INFINITY;
#pragma unroll
                for (int e = 0; e < 8; ++e) if (e != e0 && lg[e] > v1) { v1 = lg[e]; e1 = e; }
                const float ex = expf(v1 - v0), w0 = 1.f / (1.f + ex), w1 = ex / (1.f + ex);
                if (lane == 0) { GAS u32x4* rp = (GAS u32x4*)(route + (size_t)m * 8); rp[0] = (u32x4){(unsigned)e0, (unsigned)e1, 0u, 0u}; rp[1] = (u32x4){__float_as_uint(w0), __float_as_uint(w1), 0u, 0u}; }
                cnt0 += (e0 == 0) + (e1 == 0); cnt1 += (e0 == 1) + (e1 == 1); cnt2 += (e0 == 2) + (e1 == 2); cnt3 += (e0 == 3) + (e1 == 3);
                cnt4 += (e0 == 4) + (e1 == 4); cnt5 += (e0 == 5) + (e1 == 5); cnt6 += (e0 == 6) + (e1 == 6); cnt7 += (e0 == 7) + (e1 == 7); }
        }
    }
    if (MODE == 2) {
        if (lane < 8) { const int c = lane == 0 ? cnt0 : lane == 1 ? cnt1 : lane == 2 ? cnt2 : lane == 3 ? cnt3 : lane == 4 ? cnt4 : lane == 5 ? cnt5 : lane == 6 ? cnt6 : cnt7; wcnt[F.wave * 8 + lane] = c; }
        __syncthreads();
        if (F.tid < 8) { int tot = 0;
#pragma unroll
            for (int w = 0; w < 8; ++w) tot += wcnt[w * 8 + F.tid];
            int run = (int)__hip_atomic_fetch_add((unsigned*)(F.ctl + CW_ECNT + 64 * F.tid), (unsigned)tot, RLX_AGENT);
#pragma unroll
            for (int w = 0; w < 8; ++w) { wbase[w * 8 + F.tid] = run; run += wcnt[w * 8 + F.tid]; } }
        __syncthreads();
        if (lane == 0) { int* rowtok = (int*)(F.ws + WS_ROWTOK); VM_WAIT();
            for (int m = gw; m < MTOK; m += NGW) { unsigned* rp = route + (size_t)m * 8; const int e0 = (int)rp[0], e1 = (int)rp[1];
                const int s0 = wbase[F.wave * 8 + e0]; wbase[F.wave * 8 + e0] = s0 + 1; const int s1 = wbase[F.wave * 8 + e1]; wbase[F.wave * 8 + e1] = s1 + 1;
                rp[2] = (unsigned)s0; rp[3] = (unsigned)s1; rowtok[e0 * MTOK + s0] = m; rowtok[e1 * MTOK + s1] = m; } }
    }
    __syncthreads();
}

__device__ __forceinline__ void fox_cum_job(Frame& F, int bh) {
    const int b = bh >> 3, h = bh & 7, tid = F.tid; const float fb = F.in[6][h];
    const float* ff = (const float*)(F.ws + WS_FFGLR) + (size_t)(b * SEQ) * 24 + h;
    LAS float* wt = (LAS float*)F.lds;
    float v[8]; float run = 0.f;
#pragma unroll
    for (int i = 0; i < 8; ++i) { run += log_sigmoid_f(ff[(size_t)(tid * 8 + i) * 24] + fb); v[i] = run; }
    float inc = run;
#pragma unroll
    for (int o = 1; o < 64; o <<= 1) { const float t = __shfl_up(inc, o); if (F.lane >= o) inc += t; }
    if (F.lane == 63) wt[F.wave] = inc;
    __syncthreads();
    float off = inc - run;
    for (int w = 0; w < F.wave; ++w) off += wt[w];
    float* cum = (float*)(F.ws + WS_CUM) + (size_t)bh * SEQ + tid * 8;
#pragma unroll
    for (int i = 0; i < 8; ++i) cum[i] = (off + v[i]) * LOG2E;
    __syncthreads();
}

__device__ __forceinline__ void fox_norm_job(Frame& F, int job) {
    const int bh = job >> 3, part = job & 7, b = bh >> 3, h = bh & 7, tok = b * SEQ + part * 512 + F.tid;
    const bf16_t* rowp = (const bf16_t*)(F.ws + WS_QKV) + (size_t)tok * NQKV + h * 64; float q2 = 0.f, k2 = 0.f;
#pragma unroll
    for (int i = 0; i < 8; ++i) { const u32x4 a = *(const u32x4*)(rowp + 8 * i), c = *(const u32x4*)(rowp + 512 + 8 * i);
        q2 += bf_lo(a.x) * bf_lo(a.x) + bf_hi(a.x) * bf_hi(a.x) + bf_lo(a.y) * bf_lo(a.y) + bf_hi(a.y) * bf_hi(a.y) + bf_lo(a.z) * bf_lo(a.z) + bf_hi(a.z) * bf_hi(a.z) + bf_lo(a.w) * bf_lo(a.w) + bf_hi(a.w) * bf_hi(a.w);
        k2 += bf_lo(c.x) * bf_lo(c.x) + bf_hi(c.x) * bf_hi(c.x) + bf_lo(c.y) * bf_lo(c.y) + bf_hi(c.y) * bf_hi(c.y) + bf_lo(c.z) * bf_lo(c.z) + bf_hi(c.z) * bf_hi(c.z) + bf_lo(c.w) * bf_lo(c.w) + bf_hi(c.w) * bf_hi(c.w); }
#pragma unroll
    for (int o = 1; o < 64; o <<= 1) { q2 = fmaxf(q2, __shfl_xor(q2, o)); k2 = fmaxf(k2, __shfl_xor(k2, o)); }
    if (F.lane == 0) { __hip_atomic_fetch_max((unsigned*)(F.ctl + CW_QK2 + 2 * bh), __float_as_uint(q2), RLX_AGENT); __hip_atomic_fetch_max((unsigned*)(F.ctl + CW_QK2 + 2 * bh + 1), __float_as_uint(k2), RLX_AGENT); }
}
constexpr int GL_ST = 72;
__device__ __forceinline__ bf16x8 lds_frag(const LAS bf16_t* X, int row, int k0) { return *(const LAS bf16x8*)(X + row * GL_ST + k0); }
__device__ __forceinline__ float fast_exp2(float x) { return __builtin_amdgcn_exp2f(x); }
__device__ __forceinline__ float logsig16(float x) { return (fminf(x, 0.f) - 0.6931471805599453f * __builtin_amdgcn_logf(1.f + fast_exp2(-fabsf(x) * LOG2E))) * 0.0625f; }
struct Gla1In { f32x4 glr[4]; u32x4 k, v0, v1; };
__device__ __forceinline__ void gla1_load(Frame& F, int unit, Gla1In& I) {
    const int bh = unit >> 6, c = unit & 63, b = bh >> 2, hg = bh & 3, tok = b * SEQ + c * 64 + F.lane;
    const float* gp = (const float*)(F.ws + WS_FFGLR) + (size_t)tok * 24 + 8;
#pragma unroll
    for (int i = 0; i < 4; ++i) I.glr[i] = *(const f32x4*)(gp + 4 * i);
    const bf16_t* rp = (const bf16_t*)(F.ws + WS_QKV) + (size_t)tok * NQKV;
    I.k = *(const u32x4*)(rp + 1792 + hg * 64 + 8 * F.wave); I.v0 = *(const u32x4*)(rp + 2048 + hg * 128 + 16 * F.wave); I.v1 = *(const u32x4*)(rp + 2048 + hg * 128 + 16 * F.wave + 8);
}
__device__ __forceinline__ void gla1_phase(Frame& F) {
    LAS float* W2 = (LAS float*)F.lds;
    LAS float* B2 = W2 + 4096;
    LAS bf16_t* XAb = (LAS bf16_t*)(F.lds + 17408);
    LAS bf16_t* XVb = XAb + 2 * 64 * GL_ST;
    for (int i = F.tid; i < 4096; i += NTHR) W2[i] = F.in[7][i];
    if (F.tid < 256) B2[F.tid] = F.in[8][F.tid];
    int unit = blockIdx.x; if (unit >= 1024) { __syncthreads(); return; }
    Gla1In I; gla1_load(F, unit, I);
    __syncthreads();
    const int w = F.wave, lane = F.lane, r32 = lane & 31, hi = lane >> 5; int par = 0;
    float* Bbuf = (float*)(F.ws + WS_GLAB); float* ebuf = (float*)(F.ws + WS_GLAEB);
    for (;;) {
        const int hg = (unit >> 6) & 3; LAS bf16_t* XA = XAb + par * 64 * GL_ST; LAS bf16_t* XV = XVb + par * 128 * GL_ST;
        float bv[8];
        { const float g_[16] = {I.glr[0].x, I.glr[0].y, I.glr[0].z, I.glr[0].w, I.glr[1].x, I.glr[1].y, I.glr[1].z, I.glr[1].w, I.glr[2].x, I.glr[2].y, I.glr[2].z, I.glr[2].w, I.glr[3].x, I.glr[3].y, I.glr[3].z, I.glr[3].w};
            const LAS float* wp = W2 + hg * 64 + 8 * w; const f32x4 c0 = *(const LAS f32x4*)(B2 + hg * 64 + 8 * w), c1 = *(const LAS f32x4*)(B2 + hg * 64 + 8 * w + 4);
            float a[8] = {c0.x, c0.y, c0.z, c0.w, c1.x, c1.y, c1.z, c1.w};
#pragma unroll
            for (int r = 0; r < 16; ++r) { const f32x4 w0 = *(const LAS f32x4*)(wp + r * 256), w1 = *(const LAS f32x4*)(wp + r * 256 + 4);
                a[0] += g_[r] * w0.x; a[1] += g_[r] * w0.y; a[2] += g_[r] * w0.z; a[3] += g_[r] * w0.w; a[4] += g_[r] * w1.x; a[5] += g_[r] * w1.y; a[6] += g_[r] * w1.z; a[7] += g_[r] * w1.w; }
#pragma unroll
            for (int j = 0; j < 8; ++j) { float x = logsig16(a[j]);
#pragma unroll
                for (int o = 1; o < 64; o <<= 1) { const float t = __shfl_up(x, o); if (lane >= o) x += t; }
                bv[j] = x; } }
        float bl[8];
#pragma unroll
        for (int j = 0; j < 8; ++j) bl[j] = __shfl(bv[j], 63);
        { float* bp = Bbuf + ((size_t)unit * 64 + lane) * 64 + 8 * w; *(f32x4*)bp = (f32x4){bv[0], bv[1], bv[2], bv[3]}; *(f32x4*)(bp + 4) = (f32x4){bv[4], bv[5], bv[6], bv[7]}; }
        if (lane == 63) { float* ep = ebuf + (size_t)unit * 64 + 8 * w;
            *(f32x4*)ep = (f32x4){fast_exp2(bl[0] * LOG2E), fast_exp2(bl[1] * LOG2E), fast_exp2(bl[2] * LOG2E), fast_exp2(bl[3] * LOG2E)};
            *(f32x4*)(ep + 4) = (f32x4){fast_exp2(bl[4] * LOG2E), fast_exp2(bl[5] * LOG2E), fast_exp2(bl[6] * LOG2E), fast_exp2(bl[7] * LOG2E)}; }
        { const unsigned kw[4] = {I.k.x, I.k.y, I.k.z, I.k.w};
#pragma unroll
            for (int q = 0; q < 4; ++q) { const float k0 = bf_lo(kw[q]) * fast_exp2((bl[2 * q] - bv[2 * q]) * LOG2E), k1 = bf_hi(kw[q]) * fast_exp2((bl[2 * q + 1] - bv[2 * q + 1]) * LOG2E); const unsigned pk = cvt_pk_bf16(k0, k1);
                XA[(8 * w + 2 * q) * GL_ST + lane] = (bf16_t)(pk & 0xffffu); XA[(8 * w + 2 * q + 1) * GL_ST + lane] = (bf16_t)(pk >> 16); }
            const unsigned vw[8] = {I.v0.x, I.v0.y, I.v0.z, I.v0.w, I.v1.x, I.v1.y, I.v1.z, I.v1.w};
#pragma unroll
            for (int q = 0; q < 8; ++q) { XV[(16 * w + 2 * q) * GL_ST + lane] = (bf16_t)(vw[q] & 0xffffu); XV[(16 * w + 2 * q + 1) * GL_ST + lane] = (bf16_t)(vw[q] >> 16); } }
        const int nextu = unit + F.G; const bool more = nextu < 1024;
        if (more) gla1_load(F, nextu, I);
        __syncthreads();
        { const int mb = w >> 2, nb = w & 3; f32x16 acc = {};
#pragma unroll
            for (int ks = 0; ks < 4; ++ks) acc = __builtin_amdgcn_mfma_f32_32x32x16_bf16(lds_frag(XA, mb * 32 + r32, ks * 16 + hi * 8), lds_frag(XV, nb * 32 + r32, ks * 16 + hi * 8), acc, 0, 0, 0);
            float* S = F.out + (size_t)unit * 8192;
#pragma unroll
            for (int r = 0; r < 16; ++r) S[(mb * 32 + (r & 3) + 8 * (r >> 2) + 4 * hi) * 128 + nb * 32 + r32] = acc[r]; }
        if (!more) break;
        unit = nextu; par ^= 1;
    }
    __syncthreads();
}
__device__ __forceinline__ void gla2_phase(Frame& F) {
    float* S = F.out; const float* eb = (const float*)(F.ws + WS_GLAEB);
    for (int e = blockIdx.x * NTHR + F.tid; e < 16 * 8192; e += F.G * NTHR) {
        const int bh = e >> 13, dv = e & 8191, d = dv >> 7; float st = 0.f;
        float* p = S + (size_t)bh * 64 * 8192 + dv; const float* q = eb + (size_t)bh * 64 * 64 + d;
#pragma unroll 8
        for (int c = 0; c < 64; ++c) { const float t = p[(size_t)c * 8192]; p[(size_t)c * 8192] = st; st = q[c * 64] * st + t; } }
}
struct Gla3In { f32x4 b0, b1; u32x4 q, k, v0, v1; f32x4 s[4]; u32x4 g0, g1; };
__device__ __forceinline__ void gla3_load(Frame& F, int unit, Gla3In& I) {
    const int bh = unit >> 6, c = unit & 63, b = bh >> 2, hg = bh & 3, tok0 = b * SEQ + c * 64, w = F.wave, lane = F.lane;
    const float* bp = (const float*)(F.ws + WS_GLAB) + ((size_t)unit * 64 + lane) * 64 + 8 * w; I.b0 = *(const f32x4*)bp; I.b1 = *(const f32x4*)(bp + 4);
    const bf16_t* rp = (const bf16_t*)(F.ws + WS_QKV) + (size_t)(tok0 + lane) * NQKV;
    I.q = *(const u32x4*)(rp + 1536 + hg * 64 + 8 * w); I.k = *(const u32x4*)(rp + 1792 + hg * 64 + 8 * w);
    I.v0 = *(const u32x4*)(rp + 2048 + hg * 128 + 16 * w); I.v1 = *(const u32x4*)(rp + 2048 + hg * 128 + 16 * w + 8);
    const float* sp = F.out + (size_t)unit * 8192 + lane * 128 + 16 * w;
#pragma unroll
    for (int i = 0; i < 4; ++i) I.s[i] = *(const f32x4*)(sp + 4 * i);
    const bf16_t* gp = (const bf16_t*)(F.ws + WS_QKV) + (size_t)(tok0 + (F.tid >> 3)) * NQKV + 2560 + hg * 128 + (F.tid & 7) * 16; I.g0 = *(const u32x4*)gp; I.g1 = *(const u32x4*)(gp + 8);
}
__device__ __forceinline__ void gla3_phase(Frame& F) {
    LAS bf16_t* XA = (LAS bf16_t*)F.lds;
    LAS bf16_t* XB = XA + 64 * GL_ST;
    LAS bf16_t* XV = XB + 64 * GL_ST;
    LAS bf16_t* XS = XV + 128 * GL_ST;
    LAS float* OL = (LAS float*)(F.lds + 55296);
    int unit = blockIdx.x; if (unit >= 1024) return;
    Gla3In I; gla3_load(F, unit, I);
    const int w = F.wave, lane = F.lane, r32 = lane & 31, hi = lane >> 5, tid = F.tid;
    for (;;) {
        const int bh = unit >> 6, c = unit & 63, b = bh >> 2, hg = bh & 3, tok0 = b * SEQ + c * 64;
        { const float bb[8] = {I.b0.x, I.b0.y, I.b0.z, I.b0.w, I.b1.x, I.b1.y, I.b1.z, I.b1.w}; const unsigned qw[4] = {I.q.x, I.q.y, I.q.z, I.q.w}, kw[4] = {I.k.x, I.k.y, I.k.z, I.k.w}; unsigned oq[4], ok[4];
#pragma unroll
            for (int q = 0; q < 4; ++q) { const float e0 = bb[2 * q] * LOG2E, e1 = bb[2 * q + 1] * LOG2E;
                oq[q] = cvt_pk_bf16(bf_lo(qw[q]) * 0.125f * fast_exp2(e0), bf_hi(qw[q]) * 0.125f * fast_exp2(e1)); ok[q] = cvt_pk_bf16(bf_lo(kw[q]) * fast_exp2(-e0), bf_hi(kw[q]) * fast_exp2(-e1)); }
            *(LAS u32x4*)(XA + lane * GL_ST + 8 * w) = (u32x4){oq[0], oq[1], oq[2], oq[3]}; *(LAS u32x4*)(XB + lane * GL_ST + 8 * w) = (u32x4){ok[0], ok[1], ok[2], ok[3]};
            const unsigned vw[8] = {I.v0.x, I.v0.y, I.v0.z, I.v0.w, I.v1.x, I.v1.y, I.v1.z, I.v1.w};
#pragma unroll
            for (int q = 0; q < 8; ++q) { XV[(16 * w + 2 * q) * GL_ST + lane] = (bf16_t)(vw[q] & 0xffffu); XV[(16 * w + 2 * q + 1) * GL_ST + lane] = (bf16_t)(vw[q] >> 16); }
#pragma unroll
            for (int q = 0; q < 4; ++q) { const unsigned p0 = cvt_pk_bf16(I.s[q].x, I.s[q].y), p1 = cvt_pk_bf16(I.s[q].z, I.s[q].w);
                XS[(16 * w + 4 * q) * GL_ST + lane] = (bf16_t)(p0 & 0xffffu); XS[(16 * w + 4 * q + 1) * GL_ST + lane] = (bf16_t)(p0 >> 16); XS[(16 * w + 4 * q + 2) * GL_ST + lane] = (bf16_t)(p1 & 0xffffu); XS[(16 * w + 4 * q + 3) * GL_ST + lane] = (bf16_t)(p1 >> 16); } }
        const u32x4 g0 = I.g0, g1 = I.g1;
        const int nextu = unit + F.G; const bool more = nextu < 1024;
        if (more) gla3_load(F, nextu, I);
        __syncthreads();
        { const int mb = w >> 2, nb = w & 3; f32x16 o = {};
#pragma unroll
            for (int sb = 0; sb < 2; ++sb) { f32x16 st = {};
#pragma unroll
                for (int ks = 0; ks < 4; ++ks) st = __builtin_amdgcn_mfma_f32_32x32x16_bf16(lds_frag(XB, sb * 32 + r32, ks * 16 + hi * 8), lds_frag(XA, mb * 32 + r32, ks * 16 + hi * 8), st, 0, 0, 0);
                const int tq = mb * 32 + r32;
#pragma unroll
                for (int r = 0; r < 16; ++r) { const int sr = sb * 32 + (r & 3) + 8 * (r >> 2) + 4 * hi; st[r] = (sr <= tq) ? st[r] : 0.f; }
#pragma unroll
                for (int hf = 0; hf < 2; ++hf) {
                    const u32x4 pw = (u32x4){cvt_pk_bf16(st[8 * hf], st[8 * hf + 1]), cvt_pk_bf16(st[8 * hf + 2], st[8 * hf + 3]), cvt_pk_bf16(st[8 * hf + 4], st[8 * hf + 5]), cvt_pk_bf16(st[8 * hf + 6], st[8 * hf + 7])};
                    const LAS bf16_t* vp = XV + (nb * 32 + r32) * GL_ST + sb * 32 + 16 * hf + 4 * hi;
                    const u32x2 va = *(const LAS u32x2*)vp, vb = *(const LAS u32x2*)(vp + 8);
                    const u32x4 vf = (u32x4){va.x, va.y, vb.x, vb.y};
                    o = __builtin_amdgcn_mfma_f32_32x32x16_bf16(__builtin_bit_cast(bf16x8, pw), __builtin_bit_cast(bf16x8, vf), o, 0, 0, 0); } }
#pragma unroll
            for (int ks = 0; ks < 4; ++ks) o = __builtin_amdgcn_mfma_f32_32x32x16_bf16(lds_frag(XA, mb * 32 + r32, ks * 16 + hi * 8), lds_frag(XS, nb * 32 + r32, ks * 16 + hi * 8), o, 0, 0, 0);
#pragma unroll
            for (int r = 0; r < 16; ++r) OL[(mb * 32 + (r & 3) + 8 * (r >> 2) + 4 * hi) * 132 + nb * 32 + r32] = o[r]; }
        __syncthreads();
        { const int t = tid >> 3, v0 = (tid & 7) * 16; float ov[16]; float ss = 0.f;
#pragma unroll
            for (int q = 0; q < 4; ++q) { const f32x4 x = *(const LAS f32x4*)(OL + t * 132 + v0 + 4 * q); ov[4 * q] = x.x; ov[4 * q + 1] = x.y; ov[4 * q + 2] = x.z; ov[4 * q + 3] = x.w; ss += (x.x * x.x + x.y * x.y) + (x.z * x.z + x.w * x.w); }
            ss += __shfl_xor(ss, 1); ss += __shfl_xor(ss, 2); ss += __shfl_xor(ss, 4);
            const float rinv = 1.f / sqrtf(ss * (1.f / 128.f) + EPS);
            const unsigned gw_[8] = {g0.x, g0.y, g0.z, g0.w, g1.x, g1.y, g1.z, g1.w}; const float* gn = F.in[9] + v0; unsigned ow[8];
#pragma unroll
            for (int q = 0; q < 8; ++q) { const float a = ov[2 * q] * rinv * gn[2 * q] * silu_f(bf_lo(gw_[q])), bb = ov[2 * q + 1] * rinv * gn[2 * q + 1] * silu_f(bf_hi(gw_[q])); ow[q] = cvt_pk_bf16(a, bb); }
            bf16_t* mp = (bf16_t*)(F.ws + WS_MIX) + (size_t)(tok0 + t) * 1024 + 512 + hg * 128 + v0;
            *(u32x4*)mp = (u32x4){ow[0], ow[1], ow[2], ow[3]}; *(u32x4*)(mp + 8) = (u32x4){ow[4], ow[5], ow[6], ow[7]}; }
        if (!more) break;
        unit = nextu;
    }
    __syncthreads();
}

__device__ __forceinline__ void s5_scan_job(Frame& F, int job) {
    const int g = job >> 2, b = job & 3, p = F.lane, seg = F.wave;
    const float* E = (const float*)(F.ws + WS_E) + ((size_t)(g * 512 + b * 128 + seg * 16)) * 128 + p;
    bf16_t* AU = (bf16_t*)(F.ws + WS_AU) + ((size_t)(g * 512 + b * 128 + seg * 16)) * 640 + 512 + p;
    const float* al = (const float*)(F.ws + WS_AL) + (size_t)(g * 64 + p) * 2; const float ar = al[0], ai = al[1];
    LAS float* se = (LAS float*)F.lds;
    float er[16], ei[16];
#pragma unroll
    for (int k = 0; k < 16; ++k) { er[k] = E[(size_t)k * 128]; ei[k] = E[(size_t)k * 128 + 64]; }
    float sr = 0.f, si = 0.f;
#pragma unroll
    for (int k = 0; k < 16; ++k) { const float nr = ar * sr - ai * si + er[k], ni = ar * si + ai * sr + ei[k]; sr = nr; si = ni; }
    se[(seg * 64 + p) * 2] = sr; se[(seg * 64 + p) * 2 + 1] = si;
    float pr = ar, pi = ai;
#pragma unroll
    for (int q = 0; q < 4; ++q) { const float nr = pr * pr - pi * pi, ni = 2.f * pr * pi; pr = nr; pi = ni; }
    __syncthreads();
    sr = 0.f; si = 0.f;
    for (int j = 0; j < seg; ++j) { const float xr = se[(j * 64 + p) * 2], xi = se[(j * 64 + p) * 2 + 1]; const float nr = pr * sr - pi * si + xr, ni = pr * si + pi * sr + xi; sr = nr; si = ni; }
#pragma unroll
    for (int k = 0; k < 16; ++k) { AU[(size_t)k * 640] = (bf16_t)f2bf(sr); AU[(size_t)k * 640 + 64] = (bf16_t)f2bf(si);
        const float nr = ar * sr - ai * si + er[k], ni = ar * si + ai * sr + ei[k]; sr = nr; si = ni; }
    __syncthreads();
}

__device__ __forceinline__ void moe_tile_starts(Frame& F, int* ts, int* cnt) {
    int run = 0;
#pragma unroll
    for (int e = 0; e < 8; ++e) { const int c = (int)__hip_atomic_load((unsigned*)(F.ctl + CW_ECNT + 64 * e), RLX_AGENT); cnt[e] = c; ts[e] = run; run += (c + 255) >> 8; }
    ts[8] = run;
}
template <bool MOE>
__device__ __forceinline__ void final_phase(Frame& F, const float* xsrc) {
    const int gw = F.vcu * NWAVES + F.wave, NGW = F.G * NWAVES, lane = F.lane;
    int ts[9], cnt[8]; if (MOE) moe_tile_starts(F, ts, cnt);
    const unsigned* route = (const unsigned*)(F.ws + WS_ROUTE); const bf16_t* yp = (const bf16_t*)(F.ws + WS_YPERM);
    const float* gate = (const float*)(F.ws + WS_MOD) + (size_t)3 * 4 * 3072 + 2048; const float* fw = F.in[38];
    for (int m = gw; m < MTOK; m += NGW) {
        const GAS f32x4* xr = (const GAS f32x4*)(xsrc + (size_t)m * 1024) + lane; f32x4 v[4];
#pragma unroll
        for (int j = 0; j < 4; ++j) v[j] = xr[64 * j];
        if (MOE) {
            const u32x4 r0 = *(const u32x4*)(route + (size_t)m * 8), r1 = *(const u32x4*)(route + (size_t)m * 8 + 4);
            const int e0 = (int)r0.x, e1 = (int)r0.y; const float w0 = __uint_as_float(r1.x), w1 = __uint_as_float(r1.y);
            int t0 = 0, t1 = 0;
#pragma unroll
            for (int e = 0; e < 8; ++e) { t0 = (e == e0) ? ts[e] : t0; t1 = (e == e1) ? ts[e] : t1; }
            const bf16_t* y0 = yp + (size_t)(t0 * 256 + (int)r0.z) * 1024, * y1 = yp + (size_t)(t1 * 256 + (int)r0.w) * 1024; const float* gv = gate + (size_t)(m >> 12) * 3072;
#pragma unroll
            for (int j = 0; j < 4; ++j) { const int c = 4 * lane + 256 * j; const u32x2 a = *(const u32x2*)(y0 + c), bq = *(const u32x2*)(y1 + c); const f32x4 gg = *(const f32x4*)(gv + c);
                v[j].x += gg.x * (w0 * bf_lo(a.x) + w1 * bf_lo(bq.x)); v[j].y += gg.y * (w0 * bf_hi(a.x) + w1 * bf_hi(bq.x)); v[j].z += gg.z * (w0 * bf_lo(a.y) + w1 * bf_lo(bq.y)); v[j].w += gg.w * (w0 * bf_hi(a.y) + w1 * bf_hi(bq.y)); }
        }
        float ss = 0.f;
#pragma unroll
        for (int j = 0; j < 4; ++j) ss += (v[j].x * v[j].x + v[j].y * v[j].y) + (v[j].z * v[j].z + v[j].w * v[j].w);
        const float rinv = 1.f / sqrtf(wave_sum(ss) * (1.f / 1024.f) + EPS);
        GAS f32x4* op = (GAS f32x4*)(F.out + (size_t)m * 1024) + lane;
#pragma unroll
        for (int j = 0; j < 4; ++j) { const f32x4 w = *(const f32x4*)(fw + 4 * lane + 256 * j); op[64 * j] = v[j] * rinv * w; }
    }
}
#ifndef MK_LAUNCH_PER_PHASE
#define MK_LAUNCH_PER_PHASE 0
#endif
#ifndef MK_STAGE
#define MK_STAGE 4
#endif
constexpr int NPHASE = 21;
struct Args { const float* in[39]; float* out; unsigned char* ws; int ph_lo, ph_hi; };
static_assert(sizeof(Args) == 39 * 8 + 8 + 8 + 8, "Args has no padding");

__global__ void __launch_bounds__(NTHR, 2) trunk_fwd(Args args) {
    extern __shared__ __attribute__((aligned(16))) unsigned char lds_raw[];
    Frame F;
    F.lds = (LAS unsigned char*)lds_raw;
    F.tid = threadIdx.x; F.lane = F.tid & 63; F.wave = __builtin_amdgcn_readfirstlane(F.tid >> 6);
    F.G = gridDim.x; { const int bx = blockIdx.x; F.vcu = (F.G % 8 == 0) ? (bx % 8) * (F.G / 8) + bx / 8 : bx; }
    F.ws = args.ws; F.out = args.out; F.ctl = (gu32*)(args.ws + WS_CTL);
    F.in = args.in;
    volatile LAS unsigned* MISC = (volatile LAS unsigned*)(F.lds + MISC_OFF);
    if (F.tid < 64) MISC[F.tid] = 0u;
    __syncthreads();
    if (!MK_LAUNCH_PER_PHASE) (void)xcd_barrier_post((unsigned*)(F.ctl + CW_BAR), MISC + 8);
#ifndef MK_ONLY
#define MK_ONLY -1
#endif
    const int lo = args.ph_lo, hi = args.ph_hi;
#define IN(k) ((MK_ONLY < 0 || (k) == MK_ONLY) && lo <= (k) && (k) < hi)
#if MK_LAUNCH_PER_PHASE
#define SEAM(k) do { } while (0)
#else
#define SEAM(k) do { XcdBarrier b_; b_.bar = (unsigned*)((gu32*)F.ws + CW_BAR); b_.x = xb_xcc_id(); b_.st = (volatile LAS unsigned*)(F.lds + MISC_OFF) + 8; xcd_barrier(b_); } while (0)
#endif
    unsigned char* ws = F.ws;
    const float* modv = (const float*)(ws + WS_MOD);
    bf16_t* const H = (bf16_t*)(ws + WS_H);
    const LAS unsigned* gtab = (const LAS unsigned*)(F.lds + GTAB_OFF);
    char* const ldsg = (char*)lds_raw;

    if (IN(0)) { p0_prologue(F); SEAM(0); }
#if MK_STAGE >= 1
    if (IN(1)) { norm_mod_phase<1>(F, F.in[0], F.in[2], modv + 0 * 12288, H); SEAM(1); }
    if (IN(2)) { pg8::Gemm g{H, (const bf16_t*)(ws + WS_WIN0), 1024, 1024, 0, 0}; pg8::StaticOrder S; S.init(MTOK / 256, NQKV / 256, 1, F.G, (int)blockIdx.x);
        pg8::EpiBf16 E{(bf16_t*)(ws + WS_QKV), NQKV, 2, attn_body::C2};
        pg8::gemm_phase<pg8::EpiBf16, pg8::StaticOrder, true, false>(F.lds, g, S, E, gtab); SEAM(2); }
    if (IN(3)) { for (int j = blockIdx.x; j < 256; j += F.G) fox_norm_job(F, j);
        for (int j = blockIdx.x; j < 32; j += F.G) fox_cum_job(F, j);
        gla1_phase(F); SEAM(3); }
    if (IN(4)) { if (blockIdx.x == 0 && F.tid == 0) __hip_atomic_store((unsigned*)(F.ctl + CW_AQ), 0u, RLX_AGENT);
        gla2_phase(F); SEAM(4); }
    if (IN(5)) { gla3_phase(F);
        const attn_body::bf16* qkv = (const attn_body::bf16*)(ws + WS_QKV);
        const attn_body::AttnTensors AT{qkv, qkv + 512, qkv + 1024, (attn_body::bf16*)(ws + WS_MIX), (const float*)(ws + WS_CUM), (const unsigned*)(F.ctl + CW_QK2), (unsigned*)(F.ctl + CW_AQ)};
        attn_body::attn_phase<8>(ldsg, AT); SEAM(5); }
    if (IN(6)) { pg8::Gemm g{(const bf16_t*)(ws + WS_MIX), (const bf16_t*)(ws + WS_WO0), 1024, 1024, 0, 0}; pg8::StaticOrder S; S.init(MTOK / 256, 4, 1, F.G, (int)blockIdx.x);
        pg8::EpiResid E{F.in[0], F.out, modv + 0 * 12288 + 2048};
        pg8::gemm_phase<pg8::EpiResid, pg8::StaticOrder, false, false>(F.lds, g, S, E, gtab); SEAM(6); }
#endif
#if MK_STAGE >= 2
    if (IN(7)) { norm_mod_phase<0>(F, F.out, F.in[11], modv + 1 * 12288, H); SEAM(7); }
    if (IN(8)) { pg8::Gemm g{H, (const bf16_t*)(ws + WS_WGU0), 1024, 1024, 0, 0}; pg8::StaticOrder S; S.init(MTOK / 256, 22, 1, F.G, (int)blockIdx.x);
        pg8::EpiSwiGLU E{(bf16_t*)(ws + WS_ACT), DFF};
        pg8::gemm_phase<pg8::EpiSwiGLU, pg8::StaticOrder, true, false>(F.lds, g, S, E, gtab); SEAM(8); }
    if (IN(9)) { pg8::Gemm g{(const bf16_t*)(ws + WS_ACT), (const bf16_t*)(ws + WS_WD0), DFF, DFF, 0, 0}; pg8::StaticOrder S; S.init(MTOK / 256, 4, 1, F.G, (int)blockIdx.x);
        pg8::EpiResid E{F.out, F.out, modv + 1 * 12288 + 2048};
        pg8::gemm_phase<pg8::EpiResid, pg8::StaticOrder, false, false>(F.lds, g, S, E, gtab); SEAM(9); }
#endif
#if MK_STAGE >= 3
    if (IN(10)) { norm_mod_phase<0>(F, F.out, F.in[17], modv + 2 * 12288, H); SEAM(10); }
    if (IN(11)) { pg8::Gemm g{H, (const bf16_t*)(ws + WS_WIN1), 1024, 1024, 0, 0}; pg8::StaticOrder S; S.init(MTOK / 256, 4, 1, F.G, (int)blockIdx.x);
        pg8::EpiS5U E{(bf16_t*)(ws + WS_AU)};
        pg8::gemm_phase<pg8::EpiS5U, pg8::StaticOrder, false, false>(F.lds, g, S, E, gtab); SEAM(11); }
    if (IN(12)) { pg8::Gemm g{(const bf16_t*)(ws + WS_AU), (const bf16_t*)(ws + WS_S5WA), 640, 512, (size_t)512 * 640, (size_t)256 * 512}; pg8::StaticOrder S; S.init(2, 1, 64, F.G, (int)blockIdx.x);
        pg8::EpiS5E E{(float*)(ws + WS_E)};
        pg8::gemm_phase<pg8::EpiS5E, pg8::StaticOrder, false, false>(F.lds, g, S, E, gtab); SEAM(12); }
    if (IN(13)) { for (int j = blockIdx.x; j < 256; j += F.G) s5_scan_job(F, j); SEAM(13); }
    if (IN(14)) { pg8::Gemm g{(const bf16_t*)(ws + WS_AU), (const bf16_t*)(ws + WS_S5T), 640, 640, (size_t)512 * 640, (size_t)512 * 640}; pg8::StaticOrder S; S.init(2, 2, 64, F.G, (int)blockIdx.x);
        pg8::EpiS5Y E{(const bf16_t*)(ws + WS_AU), F.in[28], (bf16_t*)(ws + WS_YG)};
        pg8::gemm_phase<pg8::EpiS5Y, pg8::StaticOrder, false, false>(F.lds, g, S, E, gtab); SEAM(14); }
    if (IN(15)) { pg8::Gemm g{(const bf16_t*)(ws + WS_YG), (const bf16_t*)(ws + WS_WGLU), 1024, 1024, 0, 0}; pg8::StaticOrder S; S.init(MTOK / 256, 4, 1, F.G, (int)blockIdx.x);
        pg8::EpiGlu E{(const bf16_t*)(ws + WS_YG), (bf16_t*)(ws + WS_Z)};
        pg8::gemm_phase<pg8::EpiGlu, pg8::StaticOrder, false, false>(F.lds, g, S, E, gtab); SEAM(15); }
    if (IN(16)) { pg8::Gemm g{(const bf16_t*)(ws + WS_Z), (const bf16_t*)(ws + WS_WO1), 1024, 1024, 0, 0}; pg8::StaticOrder S; S.init(MTOK / 256, 4, 1, F.G, (int)blockIdx.x);
        pg8::EpiResid E{F.out, F.out, modv + 2 * 12288 + 2048};
        pg8::gemm_phase<pg8::EpiResid, pg8::StaticOrder, false, false>(F.lds, g, S, E, gtab); SEAM(16); }
#endif
#if MK_STAGE >= 4
    if (IN(17)) { norm_mod_phase<2>(F, F.out, F.in[31], modv + 3 * 12288, (bf16_t*)(ws + WS_H3)); SEAM(17); }
    if (IN(18)) { int ts[9], cnt[8]; moe_tile_starts(F, ts, cnt);
        pg8::MoeOrder S; S.init(ts, 22, F.G, (int)blockIdx.x);
        {
            LAS unsigned* gt = (LAS unsigned*)(F.lds + GTAB_OFF); const int* rowtok = (const int*)(ws + WS_ROWTOK); pg8::Unit u;
            for (int i = 0; i < 16 && S.next(i, u); ++i) if (F.tid < 256) { int base = 0, c = 0;
#pragma unroll
                for (int e = 0; e < 8; ++e) { base = (u.bt == e) ? ts[e] : base; c = (u.bt == e) ? cnt[e] : c; }
                const int sl = (u.pm - base) * 256 + F.tid; const int tok = (sl < c) ? rowtok[u.bt * MTOK + sl] : 0; gt[i * 256 + F.tid] = (unsigned)tok * 2048u; }
            __syncthreads(); }
        pg8::Gemm g{(const bf16_t*)(ws + WS_H3), (const bf16_t*)(ws + WS_WEGU), 1024, 1024, 0, (size_t)5632 * 1024};
        pg8::EpiSwiGLU E{(bf16_t*)(ws + WS_ACTP), DFF};
        pg8::gemm_phase<pg8::EpiSwiGLU, pg8::MoeOrder, true, true>(F.lds, g, S, E, gtab); SEAM(18); }
    if (IN(19)) { int ts[9], cnt[8]; moe_tile_starts(F, ts, cnt);
        pg8::MoeOrder S; S.init(ts, 4, F.G, (int)blockIdx.x);
        pg8::Gemm g{(const bf16_t*)(ws + WS_ACTP), (const bf16_t*)(ws + WS_WED), DFF, DFF, 0, (size_t)1024 * DFF};
        pg8::EpiBf16 E{(bf16_t*)(ws + WS_YPERM), 1024, 0, 1.f};
        pg8::gemm_phase<pg8::EpiBf16, pg8::MoeOrder, false, false>(F.lds, g, S, E, gtab); SEAM(19); }
#endif
    if (IN(20)) {
#if MK_STAGE >= 4
        final_phase<true>(F, F.out);
#elif MK_STAGE >= 1
        final_phase<false>(F, F.out);
#else
        final_phase<false>(F, F.in[0]);
#endif
    }
#undef IN
#undef SEAM
}

extern "C" void kernel_launch(void* const* d_in, const int* in_sizes, int n_in, void* d_out, int out_size, void* d_ws, size_t ws_size, hipStream_t stream) {
    static int grid = 0;
    if (grid == 0) {
        if (n_in != 39 || in_sizes[0] != MTOK * DMODEL || out_size != MTOK * DMODEL || ws_size < WS_END) {
            fprintf(stderr, "kernel_launch: shape/workspace mismatch: n_in %d in0 %d out %d ws %zu (need %zu); nothing launched\n", n_in, n_in > 0 ? in_sizes[0] : -1, out_size, ws_size, (size_t)WS_END); grid = -1; return; }
        int dev = 0, cus = 0, per_cu = 0;
        if (hipGetDevice(&dev) != hipSuccess || hipDeviceGetAttribute(&cus, hipDeviceAttributeMultiprocessorCount, dev) != hipSuccess) { grid = -1; return; }
        if (hipFuncSetAttribute((const void*)trunk_fwd, hipFuncAttributeMaxDynamicSharedMemorySize, LDS_BYTES) != hipSuccess) { fprintf(stderr, "kernel_launch: hipFuncSetAttribute failed\n"); grid = -1; return; }
        if (hipOccupancyMaxActiveBlocksPerMultiprocessor(&per_cu, (const void*)trunk_fwd, NTHR, LDS_BYTES) != hipSuccess || per_cu < 1)
            fprintf(stderr, "kernel_launch: note: occupancy query reports %d workgroups per CU\n", per_cu);
        (void)hipGetLastError();
        grid = cus;
    }
    if (grid < 0) return;
    if (hipMemsetAsync((char*)d_ws + WS_CTL, 0, CTL_ZERO_BYTES, stream) != hipSuccess) return;
    Args a{};
    for (int i = 0; i < 39; ++i) a.in[i] = (const float*)d_in[i];
    a.out = (float*)d_out; a.ws = (unsigned char*)d_ws;
#if MK_LAUNCH_PER_PHASE
    for (int p = 0; p < NPHASE; ++p) { a.ph_lo = p; a.ph_hi = p + 1; hipLaunchKernelGGL(trunk_fwd, dim3(grid), dim3(NTHR), LDS_BYTES, stream, a);
#if defined(MK_DUP_A) && defined(MK_DUP_B)
        if (p == MK_DUP_B) for (int q = MK_DUP_A; q <= MK_DUP_B; ++q) { a.ph_lo = q; a.ph_hi = q + 1; hipLaunchKernelGGL(trunk_fwd, dim3(grid), dim3(NTHR), LDS_BYTES, stream, a); }
#endif
    }
#else
    a.ph_lo = 0; a.ph_hi = NPHASE; hipLaunchKernelGGL(trunk_fwd, dim3(grid), dim3(NTHR), LDS_BYTES, stream, a);
#endif
}
```

```cpp
#define MK_LAUNCH_PER_PHASE 0
#define MK_STAGE 4
#include <hip/hip_runtime.h>
#include <hip/hip_bf16.h>
#include <cstdio>
#include <cstdint>
#include <cmath>

#define LAS __attribute__((address_space(3)))
#define GAS __attribute__((address_space(1)))
typedef unsigned short bf16_t;
typedef short bf16x8 __attribute__((ext_vector_type(8)));
typedef float f32x4 __attribute__((ext_vector_type(4)));
typedef float f32x2 __attribute__((ext_vector_type(2)));
typedef float f32x16 __attribute__((ext_vector_type(16)));
typedef unsigned u32x4 __attribute__((ext_vector_type(4)));
typedef unsigned u32x2 __attribute__((ext_vector_type(2)));
typedef int i32x4 __attribute__((ext_vector_type(4)));
typedef int i32x8 __attribute__((ext_vector_type(8)));

__device__ __forceinline__ unsigned cvt_pk_bf16(float lo, float hi) { unsigned r; asm volatile("v_cvt_pk_bf16_f32 %0, %1, %2" : "=v"(r) : "v"(lo), "v"(hi)); return r; }
__device__ __forceinline__ unsigned cvt4_fp8(float a, float b, float c, float d) {
    a = __builtin_amdgcn_fmed3f(a, -448.f, 448.f); b = __builtin_amdgcn_fmed3f(b, -448.f, 448.f); c = __builtin_amdgcn_fmed3f(c, -448.f, 448.f); d = __builtin_amdgcn_fmed3f(d, -448.f, 448.f);
    int p = 0; p = __builtin_amdgcn_cvt_pk_fp8_f32(a, b, p, false); p = __builtin_amdgcn_cvt_pk_fp8_f32(c, d, p, true); return (unsigned)p; }
constexpr float FP8_ACT_SCALE = 16.f, FP8_W_SCALE = 1024.f;
__device__ __forceinline__ float bf_lo(unsigned w) { return __uint_as_float(w << 16); }
__device__ __forceinline__ float bf_hi(unsigned w) { return __uint_as_float(w & 0xffff0000u); }
__device__ __forceinline__ float fast_exp(float x) { return __builtin_amdgcn_exp2f(x * 1.4426950408889634f); }
__device__ __forceinline__ float fast_sigmoid(float x) { return __builtin_amdgcn_rcpf(1.0f + fast_exp(-x)); }
__device__ __forceinline__ float silu_f(float x) { return x * fast_sigmoid(x); }
__device__ __forceinline__ float gelu_tanh_f(float y) { const float t = 1.5957691216057308f * (y + 0.044715f * y * y * y); return y * fast_sigmoid(t); }

namespace pg8 {
constexpr int BM = 256, BK = 64, HALF = 128, HTB = HALF * BK * 2, STAGE_BYTES = 8 * HTB, NXCD = 8, WGM = 8;
__host__ __device__ __forceinline__ int lds_byte(int r, int c) { const int st = (r >> 4) * 2 + (c >> 5), rr = r & 15, cc = c & 31, ob = rr * 64 + cc * 2; return st * 1024 + (ob ^ (((ob >> 9) & 1) << 5)); }
__host__ __device__ __forceinline__ void stage_rc(int b, int& R, int& C) { const int st = b / 1024, sb = b % 1024, swz = sb ^ (((sb >> 9) & 1) << 5); R = (st >> 1) * 16 + swz / 64; C = (st & 1) * 32 + (swz % 64) / 2; }
__host__ __device__ __forceinline__ int perm32(int rho) { const int n = rho >> 4, i = rho & 15; return 8 * (i >> 2) + 4 * n + (i & 3); }

struct Unit { int pm, pn, bt, ko; };
struct Gemm { const bf16_t* A; const bf16_t* Bt; int lda, ldb, K; size_t sA, sB; };

struct StaticOrder {
    int nM, nN, nwg, G, c;
    __device__ __forceinline__ void init(int nM_, int nN_, int nb, int G_, int c_) { nM = nM_; nN = nN_; nwg = nM * nN * nb; G = G_; c = c_; }
    __device__ __forceinline__ bool next(int i, Unit& u) const {
        const long L = (long)i * G + c; if (L >= nwg) return false;
        int wgid = (int)L; { const int q = nwg / NXCD, r = nwg % NXCD, xcd = wgid % NXCD, off = wgid / NXCD; wgid = (xcd < r ? xcd * (q + 1) : r * (q + 1) + (xcd - r) * q) + off; }
        const int per = nM * nN; u.bt = wgid / per; wgid -= u.bt * per;
        const int nig = WGM * nN, gid = wgid / nig, fm = gid * WGM, gsz = (nM - fm) < WGM ? (nM - fm) : WGM;
        u.pm = fm + ((wgid % nig) % gsz); u.pn = (wgid % nig) / gsz; u.ko = 0; return true;
    }
};
struct MoeOrder {
    int nN, nwg, G, c, nM, ks, kh; int ts[9];
    __device__ __forceinline__ void init(const int* tstart, int nN_, int G_, int c_, int ks_, int kh_) {
#pragma unroll
        for (int e = 0; e < 9; ++e) ts[e] = tstart[e];
        nM = ts[8]; nN = nN_; ks = ks_; kh = kh_; nwg = nM * nN * ks; G = G_; c = c_; }
    __device__ __forceinline__ bool next(int i, Unit& u) const {
        const long L = (long)i * G + c; if (L >= nwg) return false;
        int wgid = (int)L; { const int q = nwg / NXCD, r = nwg % NXCD, xcd = wgid % NXCD, off = wgid / NXCD; wgid = (xcd < r ? xcd * (q + 1) : r * (q + 1) + (xcd - r) * q) + off; }
        const int per = nM * nN, sp = wgid / per; wgid -= sp * per; u.ko = sp * kh;
        const int nig = WGM * nN, gid = wgid / nig, fm = gid * WGM, gsz = (nM - fm) < WGM ? (nM - fm) : WGM;
        u.pm = fm + ((wgid % nig) % gsz); u.pn = (wgid % nig) / gsz;
        int e = 0;
#pragma unroll
        for (int k = 1; k < 8; ++k) e += (u.pm >= ts[k]) ? 1 : 0;
        u.bt = e; return true;
    }
};

template <class Epi, class Sched, bool ALIGN_EPI, bool GATHER, int ES = 2>
__device__ __forceinline__ void gemm_phase(LAS unsigned char* lds, const Gemm g, const Sched& S, const Epi& E, const LAS unsigned* gtab) {
    const int tid = threadIdx.x, wid = __builtin_amdgcn_readfirstlane(tid >> 6), lane = tid & 63, wr = wid >> 2, wc = wid & 3, fr = lane & 15, fq = lane >> 4;
    const int K = g.K, nt = (K * ES) / (BK * 2), lda = g.lda, ldb = g.ldb;
    unsigned voffB[2], oA[2][2], oN[2][2]; int Rr[2], Cc[2];
    const size_t hstepA = (size_t)HALF * lda * ES, hstepB = (size_t)HALF * ldb * ES;
#pragma unroll
    for (int i = 0; i < 2; ++i) { int R, C; stage_rc(tid * 16 + i * 8192, R, C); const int Rb = Epi::PERM ? ((R & ~31) + perm32(R & 31)) : R; Rr[i] = R; Cc[i] = C;
        voffB[i] = (unsigned)(Rb * ldb * ES + C * 2); oA[0][i] = (unsigned)(R * lda * ES + C * 2); oA[1][i] = oA[0][i] + (unsigned)hstepA; oN[0][i] = oA[0][i]; oN[1][i] = oA[1][i]; }
    const size_t kstep = (size_t)(BK * 2);
    const size_t tstepA = 2 * hstepA, tstepB = 2 * hstepB;
    const unsigned ldsw = (unsigned)wid * 1024u;
    const int aoff = lds_byte(wr * 64 + fr, fq * 8), boff = lds_byte(wc * 32 + fr, fq * 8);
#define PG8_SA(b, h) (((b) * 2 + (h)) * HTB)
#define PG8_SB(b, h) ((4 + (b) * 2 + (h)) * HTB)
#define PG8_STAGE(bufoff, gbase, voff) do { _Pragma("unroll") for (int _i = 0; _i < 2; ++_i) \
        __builtin_amdgcn_global_load_lds((const unsigned*)((const char*)(gbase) + (voff)[_i]), (LAS unsigned*)(lds + (bufoff) + ldsw + _i * 8192), 16, 0, 0); } while (0)
#define PG8_LD8(base) __builtin_shufflevector(*(const LAS i32x4*)(base), *(const LAS i32x4*)((base) + 1024), 0, 1, 2, 3, 4, 5, 6, 7)
#define PG8_LDA(dst, b, h) do { _Pragma("unroll") for (int m = 0; m < 4; ++m) dst[m] = PG8_LD8(lds + PG8_SA(b, h) + aoff + m * 2048); } while (0)
#define PG8_LDB(dst, b, h) do { _Pragma("unroll") for (int n = 0; n < 2; ++n) dst[n] = PG8_LD8(lds + PG8_SB(b, h) + boff + n * 2048); } while (0)
#define PG8_LO(x) __builtin_bit_cast(bf16x8, __builtin_shufflevector(x, x, 0, 1, 2, 3))
#define PG8_HI(x) __builtin_bit_cast(bf16x8, __builtin_shufflevector(x, x, 4, 5, 6, 7))
#define PG8_MMA(ai, bj, At, Bt) do { __builtin_amdgcn_s_setprio(1); _Pragma("unroll") for (int m = 0; m < 4; ++m) _Pragma("unroll") for (int n = 0; n < 2; ++n) { if constexpr (ES == 2) { \
        acc[ai][bj][m][n] = __builtin_amdgcn_mfma_f32_16x16x32_bf16(PG8_LO(Bt[n]), PG8_LO(At[m]), acc[ai][bj][m][n], 0, 0, 0); \
        acc[ai][bj][m][n] = __builtin_amdgcn_mfma_f32_16x16x32_bf16(PG8_HI(Bt[n]), PG8_HI(At[m]), acc[ai][bj][m][n], 0, 0, 0); } else { \
        asm volatile("v_mfma_scale_f32_16x16x128_f8f6f4 %0, %1, %2, %0, %3, %3 op_sel_hi:[0,0,0]" : "+v"(acc[ai][bj][m][n]) : "v"(Bt[n]), "v"(At[m]), "v"(f8one)); } } __builtin_amdgcn_s_setprio(0); } while (0)
#define PG8_WAIT_V(n) asm volatile("s_waitcnt vmcnt(" #n ")" ::: "memory")
#define PG8_WAIT_L(n) asm volatile("s_waitcnt lgkmcnt(" #n ")" ::: "memory")
#define PG8_BAR __builtin_amdgcn_s_barrier()
#define PG8_SCHED __builtin_amdgcn_sched_barrier(0)
#define PG8_GOFF(dst, ord) do { if constexpr (GATHER) { _Pragma("unroll") for (int _h = 0; _h < 2; ++_h) _Pragma("unroll") for (int _i = 0; _i < 2; ++_i) dst[_h][_i] = gtab[(ord) * 256 + Rr[_i] + 128 * _h] + (unsigned)Cc[_i] * 2u; } } while (0)
    Unit cur, nxt; int ui = 0;
    if (!S.next(0, cur)) return;
    f32x4 acc[2][2][4][2];
#pragma unroll
    for (int a = 0; a < 2; ++a)
#pragma unroll
        for (int b = 0; b < 2; ++b)
#pragma unroll
            for (int m = 0; m < 4; ++m)
#pragma unroll
                for (int n = 0; n < 2; ++n) acc[a][b][m][n] = (f32x4){0.f, 0.f, 0.f, 0.f};
    int f8one = 0x7f7f7f7f; asm volatile("" : "+v"(f8one));
    i32x8 At[4], B0[2], B1[2];
    const char* cA = (const char*)g.A + (size_t)cur.ko * ES + (GATHER ? (size_t)0 : ((size_t)cur.bt * g.sA * ES + (size_t)cur.pm * tstepA));
    const char* cB = (const char*)g.Bt + (size_t)cur.ko * ES + (size_t)cur.bt * g.sB * ES + (size_t)cur.pn * tstepB;
    PG8_GOFF(oA, 0);
    PG8_STAGE(PG8_SB(0, 0), cB, voffB); PG8_STAGE(PG8_SB(0, 1), cB + hstepB, voffB); PG8_STAGE(PG8_SA(0, 0), cA, oA[0]); PG8_STAGE(PG8_SA(0, 1), cA + (GATHER ? (size_t)0 : hstepA), oA[GATHER ? 1 : 0]);
    if (wr == 1) PG8_BAR;
    PG8_WAIT_V(2); PG8_BAR;
    PG8_STAGE(PG8_SB(1, 0), cB + kstep, voffB); PG8_STAGE(PG8_SA(1, 0), cA + kstep, oA[0]); PG8_STAGE(PG8_SB(1, 1), cB + hstepB + kstep, voffB);
    PG8_WAIT_V(6); PG8_BAR;
    for (;;) {
        const bool has_next = S.next(ui + 1, nxt);
        const char* nA = has_next ? ((const char*)g.A + (size_t)nxt.ko * ES + (GATHER ? (size_t)0 : ((size_t)nxt.bt * g.sA * ES + (size_t)nxt.pm * tstepA))) : cA;
        const char* nB = has_next ? (const char*)g.Bt + (size_t)nxt.ko * ES + (size_t)nxt.bt * g.sB * ES + (size_t)nxt.pn * tstepB : cB;
        if constexpr (GATHER) { if (has_next) { PG8_GOFF(oN, ui + 1); } else {
#pragma unroll
            for (int _h = 0; _h < 2; ++_h)
#pragma unroll
                for (int _i = 0; _i < 2; ++_i) oN[_h][_i] = oA[_h][_i]; } }
#pragma clang loop unroll(disable)
        for (int t = 0; t < nt; t += 2) {
            const bool last = (t == nt - 2);
            const char* a1 = cA + (size_t)(t + 1) * kstep;
            const char* a2 = last ? nA : cA + (size_t)(t + 2) * kstep; const char* b2 = last ? nB : cB + (size_t)(t + 2) * kstep;
            const char* a3 = a2 + kstep; const char* b3 = b2 + kstep;
            unsigned o2[2][2];
#pragma unroll
            for (int _h = 0; _h < 2; ++_h)
#pragma unroll
                for (int _i = 0; _i < 2; ++_i) o2[_h][_i] = (GATHER && last) ? oN[_h][_i] : oA[_h][_i];
            PG8_LDB(B0, 0, 0); PG8_LDB(B1, 0, 1); PG8_SCHED; PG8_LDA(At, 0, 0); PG8_STAGE(PG8_SA(1, 1), a1 + (GATHER ? (size_t)0 : hstepA), oA[GATHER ? 1 : 0]);
            PG8_WAIT_V(8); PG8_WAIT_L(0); PG8_BAR; PG8_MMA(0, 0, At, B0); PG8_MMA(0, 1, At, B1); PG8_BAR; PG8_SCHED;
            PG8_LDA(At, 0, 1); PG8_STAGE(PG8_SB(0, 0), b2, voffB); PG8_STAGE(PG8_SB(0, 1), b2 + hstepB, voffB); PG8_STAGE(PG8_SA(0, 0), a2, o2[0]);
            PG8_WAIT_V(8); PG8_WAIT_L(0); PG8_BAR; PG8_MMA(1, 0, At, B0); PG8_MMA(1, 1, At, B1); PG8_BAR; PG8_SCHED;
            PG8_LDB(B0, 1, 0); PG8_LDB(B1, 1, 1); PG8_SCHED; PG8_LDA(At, 1, 0); PG8_STAGE(PG8_SA(0, 1), a2 + (GATHER ? (size_t)0 : hstepA), o2[GATHER ? 1 : 0]);
            PG8_WAIT_V(8); PG8_WAIT_L(0); PG8_BAR; PG8_MMA(0, 0, At, B0); PG8_MMA(0, 1, At, B1); PG8_BAR; PG8_SCHED;
            PG8_LDA(At, 1, 1); PG8_STAGE(PG8_SB(1, 0), b3, voffB); PG8_STAGE(PG8_SB(1, 1), b3 + hstepB, voffB); PG8_STAGE(PG8_SA(1, 0), a3, o2[0]);
            PG8_WAIT_V(8); PG8_WAIT_L(0); PG8_BAR; PG8_MMA(1, 0, At, B0); PG8_MMA(1, 1, At, B1); PG8_BAR; PG8_SCHED;
        }
        if constexpr (ALIGN_EPI) { if (wr == 0) PG8_BAR; }
        if constexpr (ES == 1) asm volatile("s_nop 15\n\ts_nop 15" ::: "memory");
        { int t2 = threadIdx.x; asm volatile("" : "+v"(t2));
          const int w2 = __builtin_amdgcn_readfirstlane(t2 >> 6), l2 = t2 & 63; E(acc, cur, w2 >> 2, w2 & 3, l2 & 15, l2 >> 4); }
        if (!has_next) break;
#pragma unroll
        for (int a = 0; a < 2; ++a)
#pragma unroll
            for (int b = 0; b < 2; ++b)
#pragma unroll
                for (int m = 0; m < 4; ++m)
#pragma unroll
                    for (int n = 0; n < 2; ++n) acc[a][b][m][n] = (f32x4){0.f, 0.f, 0.f, 0.f};
        cur = nxt; cA = nA; cB = nB; ++ui;
        if constexpr (GATHER) {
#pragma unroll
            for (int _h = 0; _h < 2; ++_h)
#pragma unroll
                for (int _i = 0; _i < 2; ++_i) oA[_h][_i] = oN[_h][_i]; }
        if constexpr (ALIGN_EPI) { if (wr == 1) PG8_BAR; }
    }
    PG8_WAIT_V(0);
    if constexpr (!ALIGN_EPI) { if (wr == 0) PG8_BAR; }
    PG8_BAR;
#undef PG8_SA
#undef PG8_SB
#undef PG8_STAGE
#undef PG8_LDA
#undef PG8_LD8
#undef PG8_LO
#undef PG8_HI
#undef PG8_LDB
#undef PG8_MMA
#undef PG8_WAIT_V
#undef PG8_WAIT_L
#undef PG8_BAR
#undef PG8_SCHED
#undef PG8_GOFF
}
}
namespace pg8 {
struct EpiBf16 {
    static constexpr bool PERM = true;
    bf16_t* O; int ldc; int nscale; float scale; size_t ksplit_stride;
    __device__ __forceinline__ void operator()(const f32x4 (&acc)[2][2][4][2], const Unit& u, int wr, int wc, int fr, int fq) const {
        const int row0 = u.pm * BM + wr * 64 + fr, col0 = u.pn * BM + wc * 32 + 8 * fq; const float sc = (u.pn < nscale) ? scale : 1.f; bf16_t* O = this->O + (u.ko ? ksplit_stride : (size_t)0);
#pragma unroll
        for (int ai = 0; ai < 2; ++ai)
#pragma unroll
            for (int m = 0; m < 4; ++m) { bf16_t* rowp = O + (size_t)(row0 + ai * HALF + m * 16) * ldc + col0;
#pragma unroll
                for (int bj = 0; bj < 2; ++bj) { const f32x4 v0 = acc[ai][bj][m][0] * sc, v1 = acc[ai][bj][m][1] * sc;
                    u32x4 w; w.x = cvt_pk_bf16(v0[0], v0[1]); w.y = cvt_pk_bf16(v0[2], v0[3]); w.z = cvt_pk_bf16(v1[0], v1[1]); w.w = cvt_pk_bf16(v1[2], v1[3]);
                    *(u32x4*)(rowp + bj * HALF) = w; } }
    }
};
struct EpiSwiGLU {
    static constexpr bool PERM = true;
    bf16_t* O; int ldc; float pre;
    __device__ __forceinline__ void operator()(const f32x4 (&acc)[2][2][4][2], const Unit& u, int wr, int wc, int fr, int fq) const {
        const int row0 = u.pm * BM + wr * 64 + fr, col0 = u.pn * HALF + wc * 32 + 8 * fq;
#pragma unroll
        for (int ai = 0; ai < 2; ++ai)
#pragma unroll
            for (int m = 0; m < 4; ++m) { bf16_t* rowp = O + (size_t)(row0 + ai * HALF + m * 16) * ldc + col0;
                float r[8];
#pragma unroll
                for (int n = 0; n < 2; ++n)
#pragma unroll
                    for (int j = 0; j < 4; ++j) { const float gt = acc[ai][0][m][n][j] * pre, up = acc[ai][1][m][n][j] * pre; r[n * 4 + j] = silu_f(gt) * up; }
                u32x4 w; w.x = cvt_pk_bf16(r[0], r[1]); w.y = cvt_pk_bf16(r[2], r[3]); w.z = cvt_pk_bf16(r[4], r[5]); w.w = cvt_pk_bf16(r[6], r[7]);
                *(u32x4*)rowp = w; }
    }
};
struct EpiResid {
    static constexpr bool PERM = false;
    const float* base; float* out; const float* gate;
    __device__ __forceinline__ void operator()(const f32x4 (&acc)[2][2][4][2], const Unit& u, int wr, int wc, int fr, int fq) const {
        const int row0 = u.pm * BM + wr * 64 + fr, col0 = u.pn * BM + wc * 32 + 4 * fq; const float* gv = gate + (size_t)(u.pm >> 4) * 3072;
#pragma unroll
        for (int bj = 0; bj < 2; ++bj)
#pragma unroll
            for (int n = 0; n < 2; ++n) { const int col = col0 + bj * HALF + n * 16; const f32x4 gg = *(const f32x4*)(gv + col);
#pragma unroll
                for (int ai = 0; ai < 2; ++ai)
#pragma unroll
                    for (int m = 0; m < 4; ++m) { const size_t off = (size_t)(row0 + ai * HALF + m * 16) * 1024 + col;
                        const f32x4 bs = *(const f32x4*)(base + off); *(f32x4*)(out + off) = bs + gg * acc[ai][bj][m][n]; } }
    }
};
struct EpiS5U {
    static constexpr bool PERM = true;
    bf16_t* AU;
    __device__ __forceinline__ void operator()(const f32x4 (&acc)[2][2][4][2], const Unit& u, int wr, int wc, int fr, int fq) const {
        const int row0 = u.pm * BM + wr * 64 + fr, col0 = u.pn * BM + wc * 32 + 8 * fq;
#pragma unroll
        for (int ai = 0; ai < 2; ++ai)
#pragma unroll
            for (int m = 0; m < 4; ++m) { const int tok = row0 + ai * HALF + m * 16;
#pragma unroll
                for (int bj = 0; bj < 2; ++bj) { const int c8 = col0 + bj * HALF, gi = c8 >> 4, k0 = c8 & 15; const f32x4 v0 = acc[ai][bj][m][0], v1 = acc[ai][bj][m][1];
                    u32x4 w; w.x = cvt_pk_bf16(v0[0], v0[1]); w.y = cvt_pk_bf16(v0[2], v0[3]); w.z = cvt_pk_bf16(v1[0], v1[1]); w.w = cvt_pk_bf16(v1[2], v1[3]);
                    *(u32x4*)(AU + ((size_t)(gi * 512 + (tok >> 5)) * 640 + (tok & 31) * 16 + k0)) = w; } }
    }
};
struct EpiS5E {
    static constexpr bool PERM = false;
    float* E;
    __device__ __forceinline__ void operator()(const f32x4 (&acc)[2][2][4][2], const Unit& u, int wr, int wc, int fr, int fq) const {
        const int row0 = u.pm * BM + wr * 64 + fr, col0 = wc * 32 + 4 * fq;
#pragma unroll
        for (int ai = 0; ai < 2; ++ai)
#pragma unroll
            for (int m = 0; m < 4; ++m)
#pragma unroll
                for (int n = 0; n < 2; ++n) *(f32x4*)(E + ((size_t)(u.bt * 512 + row0 + ai * HALF + m * 16) * 128 + col0 + n * 16)) = acc[ai][0][m][n];
    }
};
struct EpiS5Y {
    static constexpr bool PERM = true;
    const bf16_t* AU; const float* dskip; bf16_t* YG;
    __device__ __forceinline__ void operator()(const f32x4 (&acc)[2][2][4][2], const Unit& u, int wr, int wc, int fr, int fq) const {
        const int row0 = u.pm * BM + wr * 64 + fr, col0 = u.pn * BM + wc * 32 + 8 * fq;
#pragma unroll
        for (int bj = 0; bj < 2; ++bj) { const int c8 = col0 + bj * HALF, ii = c8 >> 4, k0 = c8 & 15, ch = u.bt * 16 + k0;
            const f32x4 d0 = *(const f32x4*)(dskip + ch), d1 = *(const f32x4*)(dskip + ch + 4);
#pragma unroll
            for (int ai = 0; ai < 2; ++ai)
#pragma unroll
                for (int m = 0; m < 4; ++m) { const int row = row0 + ai * HALF + m * 16;
                    const u32x4 uu = *(const u32x4*)(AU + ((size_t)(u.bt * 512 + row) * 640 + c8));
                    const f32x4 v0 = acc[ai][bj][m][0], v1 = acc[ai][bj][m][1];
                    float r[8];
                    r[0] = v0[0] + d0[0] * bf_lo(uu.x); r[1] = v0[1] + d0[1] * bf_hi(uu.x); r[2] = v0[2] + d0[2] * bf_lo(uu.y); r[3] = v0[3] + d0[3] * bf_hi(uu.y);
                    r[4] = v1[0] + d1[0] * bf_lo(uu.z); r[5] = v1[1] + d1[1] * bf_hi(uu.z); r[6] = v1[2] + d1[2] * bf_lo(uu.w); r[7] = v1[3] + d1[3] * bf_hi(uu.w);
#pragma unroll
                    for (int j = 0; j < 8; ++j) r[j] = gelu_tanh_f(r[j]);
                    u32x4 w; w.x = cvt_pk_bf16(r[0], r[1]); w.y = cvt_pk_bf16(r[2], r[3]); w.z = cvt_pk_bf16(r[4], r[5]); w.w = cvt_pk_bf16(r[6], r[7]);
                    *(u32x4*)(YG + ((size_t)(row * 32 + ii) * 1024 + ch)) = w; } }
    }
};
struct EpiGlu {
    static constexpr bool PERM = true;
    const bf16_t* YG; bf16_t* Z;
    __device__ __forceinline__ void operator()(const f32x4 (&acc)[2][2][4][2], const Unit& u, int wr, int wc, int fr, int fq) const {
        const int row0 = u.pm * BM + wr * 64 + fr, col0 = u.pn * BM + wc * 32 + 8 * fq;
#pragma unroll
        for (int ai = 0; ai < 2; ++ai)
#pragma unroll
            for (int m = 0; m < 4; ++m) { const size_t ro = (size_t)(row0 + ai * HALF + m * 16) * 1024 + col0;
#pragma unroll
                for (int bj = 0; bj < 2; ++bj) { const u32x4 yy = *(const u32x4*)(YG + ro + bj * HALF); const f32x4 v0 = acc[ai][bj][m][0], v1 = acc[ai][bj][m][1];
                    float r[8];
                    r[0] = bf_lo(yy.x) * fast_sigmoid(v0[0]); r[1] = bf_hi(yy.x) * fast_sigmoid(v0[1]); r[2] = bf_lo(yy.y) * fast_sigmoid(v0[2]); r[3] = bf_hi(yy.y) * fast_sigmoid(v0[3]);
                    r[4] = bf_lo(yy.z) * fast_sigmoid(v1[0]); r[5] = bf_hi(yy.z) * fast_sigmoid(v1[1]); r[6] = bf_lo(yy.w) * fast_sigmoid(v1[2]); r[7] = bf_hi(yy.w) * fast_sigmoid(v1[3]);
                    u32x4 w; w.x = cvt_pk_bf16(r[0], r[1]); w.y = cvt_pk_bf16(r[2], r[3]); w.z = cvt_pk_bf16(r[4], r[5]); w.w = cvt_pk_bf16(r[6], r[7]);
                    *(u32x4*)(Z + ro + bj * HALF) = w; } }
    }
};
}
namespace attn_body {
using bf16=__hip_bfloat16;
using bf16x8=__attribute__((ext_vector_type(8)))short;
using s16x4=__attribute__((ext_vector_type(4)))short;
using f32x16=__attribute__((ext_vector_type(16)))float;
using u32x4=__attribute__((ext_vector_type(4)))unsigned;
using f32x4v=__attribute__((ext_vector_type(4)))float;
constexpr int BATCH=4,NHEAD=8,SEQ=4096,D=64,PQ=3072,PO=1024;
constexpr int NW=8,QBLK=32,QB=QBLK*NW,KVBLK=64,NQB=SEQ/QB;
constexpr int ATTN_UNIT_ROWS=QB;
__device__ __forceinline__ int crow(int r,int hi){return (r&3)+8*(r>>2)+4*hi;}
#define SBAR() __builtin_amdgcn_sched_barrier(0)
__device__ __forceinline__ void cmask(f32x16&p0,f32x16&p1,int jb,int qrel,int hi){
  const float NEG=-INFINITY; int kb=64*jb+4*hi;
  #pragma unroll
  for(int r=0;r<16;++r){int kv=kb+(r&3)+8*(r>>2); if(kv>qrel)p0[r]=NEG; if(kv+32>qrel)p1[r]=NEG;}
}

constexpr int NSLOT=3, SLOTB=8192;
constexpr int LDS_K=0, LDS_V=NSLOT*SLOTB, LDS_WS=2*NSLOT*SLOTB, LDS_OST=LDS_WS+NW*64*4, LDS_CUM=LDS_OST+NW*4096, LDS_BYTES=LDS_CUM+SEQ*4;
constexpr float C2=0.125f*1.4426950408889634f;
__device__ __forceinline__ void glds16(const void*gsrc,unsigned lds_dst){unsigned keep;
  asm volatile("s_mov_b32 %0, m0\n\ts_mov_b32 m0, %2\n\ts_nop 0\n\tglobal_load_lds_dwordx4 %1, off\n\ts_mov_b32 m0, %0":"=&s"(keep):"v"(gsrc),"s"(lds_dst):"memory");}
__device__ __forceinline__ float max3f(float a,float b,float c){float r;asm("v_max3_f32 %0, %1, %2, %3":"=v"(r):"v"(a),"v"(b),"v"(c));return r;}
__device__ __forceinline__ float max2f(float a,float b){float r;asm("v_max_f32_e32 %0, %1, %2":"=v"(r):"v"(a),"v"(b));return r;}
__device__ __forceinline__ float fadd_s(float a,float b){float r;asm("v_add_f32_e32 %0, %1, %2":"=v"(r):"v"(a),"v"(b));return r;}
__device__ __forceinline__ float fsub_s(float a,float b){float r;asm("v_sub_f32_e32 %0, %1, %2":"=v"(r):"v"(a),"v"(b));return r;}
typedef float f32x2_t __attribute__((ext_vector_type(2))); typedef __bf16 bf16x2_t __attribute__((ext_vector_type(2)));
__device__ __forceinline__ unsigned cvtpk_s(float lo,float hi){f32x2_t v={lo,hi};bf16x2_t b=__builtin_convertvector(v,bf16x2_t);return __builtin_bit_cast(unsigned,b);}
#define WAIT_BAR(N) asm volatile("s_waitcnt vmcnt(" #N ") lgkmcnt(0)\n\ts_barrier":::"memory")

__device__ __forceinline__ void qkt(f32x16&p0,f32x16&p1,const char*Kslot,const bf16x8*qr,int r32,int hi){
  const char*kb=Kslot+hi*1024+r32*16;
  #pragma unroll
  for(int d0=0;d0<4;++d0){
    const bf16x8 b0=*reinterpret_cast<const bf16x8*>(kb+d0*2048);
    const bf16x8 b1=*reinterpret_cast<const bf16x8*>(kb+d0*2048+512);
    p0=__builtin_amdgcn_mfma_f32_32x32x16_bf16(b0,qr[d0],p0,0,0,0);p1=__builtin_amdgcn_mfma_f32_32x32x16_bf16(b1,qr[d0],p1,0,0,0);}
}
typedef __attribute__((address_space(3))) const char* lds_cptr;
typedef short v4i16_t __attribute__((ext_vector_type(4)));
__device__ __forceinline__ void kload8(bf16x8*kf,lds_cptr kp){
  kf[0]=*(const __attribute__((address_space(3))) bf16x8*)(kp);      kf[1]=*(const __attribute__((address_space(3))) bf16x8*)(kp+512);
  kf[2]=*(const __attribute__((address_space(3))) bf16x8*)(kp+2048); kf[3]=*(const __attribute__((address_space(3))) bf16x8*)(kp+2560);
  kf[4]=*(const __attribute__((address_space(3))) bf16x8*)(kp+4096); kf[5]=*(const __attribute__((address_space(3))) bf16x8*)(kp+4608);
  kf[6]=*(const __attribute__((address_space(3))) bf16x8*)(kp+6144); kf[7]=*(const __attribute__((address_space(3))) bf16x8*)(kp+6656);
}
__device__ __forceinline__ void kload2(bf16x8*kf,lds_cptr kp,int j){ kf[2*j]=*(const __attribute__((address_space(3))) bf16x8*)(kp+j*2048); kf[2*j+1]=*(const __attribute__((address_space(3))) bf16x8*)(kp+j*2048+512); }
__device__ __forceinline__ s16x4 vtr(lds_cptr p){ return __builtin_bit_cast(s16x4,__builtin_amdgcn_ds_read_tr16_b64_v4i16((__attribute__((address_space(3))) v4i16_t*)p)); }
__device__ __forceinline__ float rowmax(const f32x16&p0,const f32x16&p1){
  float a=max3f(p0[0],p0[1],p1[0]),b=max3f(p0[2],p0[3],p1[1]);a=max3f(a,p1[2],p1[3]);
  #pragma unroll
  for(int r=4;r<16;r+=4){a=max3f(a,p0[r],p0[r+1]);b=max3f(b,p0[r+2],p0[r+3]);a=max3f(a,p1[r],p1[r+1]);b=max3f(b,p1[r+2],p1[r+3]);}
  const float m=max2f(a,b);
  auto rr=__builtin_amdgcn_permlane32_swap(__float_as_uint(m),__float_as_uint(m),false,false);
  return max2f(__uint_as_float(rr[0]),__uint_as_float(rr[1]));
}
__device__ __forceinline__ void pv(f32x16*o,int vb,bf16x8 pa0,bf16x8 pa1,bf16x8 pa2,bf16x8 pa3){
  #pragma unroll
  for(int d0=0;d0<2;++d0){s16x4 lo[4],hi[4];
    #pragma unroll
    for(int ks=0;ks<4;++ks){
      asm volatile("ds_read_b64_tr_b16 %0,%1 offset:%c2":"=&v"(lo[ks]):"v"(vb),"i"(d0*4096+ks*1024):"memory");
      asm volatile("ds_read_b64_tr_b16 %0,%1 offset:%c2":"=&v"(hi[ks]):"v"(vb),"i"(d0*4096+ks*1024+512):"memory");}
    asm volatile("s_waitcnt lgkmcnt(0)":::"memory");SBAR();
    #define PK(k) (bf16x8){lo[k][0],lo[k][1],lo[k][2],lo[k][3],hi[k][0],hi[k][1],hi[k][2],hi[k][3]}
    o[d0]=__builtin_amdgcn_mfma_f32_32x32x16_bf16(pa0,PK(0),o[d0],0,0,0);
    o[d0]=__builtin_amdgcn_mfma_f32_32x32x16_bf16(pa1,PK(1),o[d0],0,0,0);
    o[d0]=__builtin_amdgcn_mfma_f32_32x32x16_bf16(pa2,PK(2),o[d0],0,0,0);
    o[d0]=__builtin_amdgcn_mfma_f32_32x32x16_bf16(pa3,PK(3),o[d0],0,0,0);
    #undef PK
  }
}

#ifndef ATTN_STORE16
#define ATTN_STORE16(p,v) (*(u32x4*)(p)=(v))
#endif
template<int THRL> __device__ __forceinline__ void attn_unit(int b,int h,int qb,const bf16*Q,const bf16*__restrict__ K,const bf16*__restrict__ V,bf16*O,const float*__restrict__ cumG,int t0,char*shm){
  const int tid=threadIdx.x,lane=tid&63,r32=lane&31,hi=lane>>5; const int wid=__builtin_amdgcn_readfirstlane(tid>>6);
  const long rowbase=(long)b*SEQ; const int q0=qb*QB;
  const bf16*Qw=Q+(rowbase+q0+wid*QBLK)*PQ+h*D;
  const bf16*Kh=K+(rowbase+(long)t0*KVBLK)*PQ+h*D,*Vh=V+(rowbase+(long)t0*KVBLK)*PQ+h*D;
  const unsigned lds0=(unsigned)(uintptr_t)shm;
  float*wsf=(float*)(shm+LDS_WS)+wid*64;
  const bf16*ksrc=Kh+(long)lane*PQ+wid*8;
  const bf16*vsrc=Vh+(long)(16*(wid&3)+(lane>>2))*PQ+(wid>>2)*32+(lane&3)*8;
  const unsigned kdst=lds0+LDS_K+wid*1024, vdst=lds0+LDS_V+wid*1024;
  #define DMA_K(t,slot) glds16(ksrc+(long)(t)*KVBLK*PQ,(unsigned)__builtin_amdgcn_readfirstlane(kdst+(slot)))
  #define DMA_V(t,slot) glds16(vsrc+(long)(t)*KVBLK*PQ,(unsigned)__builtin_amdgcn_readfirstlane(vdst+(slot)))
  const int vb0=(int)(lds0+LDS_V)+((lane>>4)&1)*32+(lane&3)*8+(4*hi+((lane&15)>>2))*64;
  const char*Kbase=shm+LDS_K; bf16x8 kf[8];
  const lds_cptr shm3=(lds_cptr)shm; const lds_cptr kp0=shm3+LDS_K+hi*1024+r32*16; const lds_cptr vp0=shm3+LDS_V+((lane>>4)&1)*32+(lane&3)*8+(4*hi+((lane&15)>>2))*64;
  const int NT=(q0+QB)/KVBLK-t0;
  typedef __attribute__((address_space(3))) float lds_f32; typedef __attribute__((address_space(3))) const f32x4v lds_cf4;
  { lds_f32*cl=(lds_f32*)(shm3+LDS_CUM)+tid; const float*cg_=cumG+tid; float cv_[8];
    _Pragma("unroll") for(int i=0;i<8;++i)cv_[i]=cg_[i*NW*64];
    _Pragma("unroll") for(int i=0;i<8;++i)cl[i*NW*64]=cv_[i]; }
  const lds_cptr cum3=shm3+LDS_CUM+16*hi+t0*256;
  DMA_K(0,0);DMA_V(0,0);DMA_K(1,SLOTB);
  bf16x8 qr[4];
  #pragma unroll
  for(int d0=0;d0<4;++d0)qr[d0]=*reinterpret_cast<const bf16x8*>(&Qw[(long)r32*PQ+d0*16+hi*8]);
  float mhat=0.f,l_reg=0.f,qm=0.f;f32x16 o[2];o[0]=f32x16{};o[1]=f32x16{};
  const int qrel=wid*QBLK+r32;
  #define CMASK(P0,P1,t) do{int jb_=(t)-(NT-4); if(jb_>=0)cmask(P0,P1,jb_,qrel,hi);}while(0)
  bool resc=false;
  #define START(P0,P1) do{ const float rm=rowmax(P0,P1); resc=false; \
    if(__any(rm>(float)THRL)){ const float dl=__builtin_fmaxf(rm,0.f); mhat+=dl; qm-=dl; \
      _Pragma("unroll") for(int r=0;r<16;++r){P0[r]-=dl;P1[r]-=dl;} } \
    _Pragma("unroll") for(int r=0;r<16;++r)P0[r]=__builtin_amdgcn_exp2f(P0[r]); }while(0)
  #define BIAS(P0,P1,t) do{ const lds_cptr cb_=cum3+(t)*256; \
    _Pragma("unroll") for(int g_=0;g_<4;++g_){ const f32x4v c0_=*(lds_cf4*)(cb_+g_*32), c1_=*(lds_cf4*)(cb_+128+g_*32); \
      _Pragma("unroll") for(int i_=0;i_<4;++i_){ P0[4*g_+i_]=qm-c0_[i_]; P1[4*g_+i_]=qm-c1_[i_]; } } }while(0)
  #define RESC() do{ if(resc){ asm volatile("s_waitcnt lgkmcnt(0)":::"memory"); \
      _Pragma("unroll") for(int d_=0;d_<2;++d_) _Pragma("unroll") for(int r=0;r<16;++r)o[d_][r]*=wsf[crow(r,hi)]; } }while(0)
  f32x16 pA0,pA1,pB0,pB1;
  int sl_prev=0,sl_cur=0,sl_next=SLOTB;
  #define ROT() do{sl_prev=sl_cur;sl_cur=sl_next;sl_next=(sl_next==(NSLOT-1)*SLOTB)?0:sl_next+SLOTB;}while(0)
  DMA_K(2,2*SLOTB);
  WAIT_BAR(3);
  qm=*(const __attribute__((address_space(3))) float*)(shm3+LDS_CUM+(q0+qrel)*4);
  BIAS(pA0,pA1,0);
  qkt(pA0,pA1,Kbase,qr,r32,hi);asm volatile("s_nop 15\n\ts_nop 7":"+v"(pA0),"+v"(pA1));CMASK(pA0,pA1,0);
  START(pA0,pA1);
  _Pragma("unroll") for(int r=0;r<16;++r)pA1[r]=__builtin_amdgcn_exp2f(pA1[r]);
  WAIT_BAR(0);
  DMA_K(3,0);DMA_V(1,SLOTB);
  ROT();
  kload8(kf,kp0+sl_cur);
  BIAS(pB0,pB1,1);
  WAIT_BAR(2);
  s16x4 vlo[8],vhi[8]; u32x4 pw0,pw1,pw2,pw3;
  #define PKW(P,B) cvtpk_s(P[B],P[B+1])
  #define PAF(k) __builtin_bit_cast(bf16x8,pw##k)
  #define VFR(i) (bf16x8){vlo[i][0],vlo[i][1],vlo[i][2],vlo[i][3],vhi[i][0],vhi[i][1],vhi[i][2],vhi[i][3]}
  #define PIN(x) asm volatile("":"+v"(x))
  #define MX3(a,b,c) __builtin_fmaxf(__builtin_fmaxf((a),(b)),(c))
  #define GAPA(MF,A0,A1,A2,A3,W0,W1,PW) do{ MF; sacc+=A0; sacc+=A1; sacc+=A2; sacc+=A3; PIN(sacc); W0; W1; PIN(PW); SBAR(); }while(0)
  #define EX(v) __builtin_amdgcn_exp2f(v)
  #define GAPB(MF,X,B,EXTRA) do{ MF; X[B]=EX(X[B]); X[B+1]=EX(X[B+1]); X[B+2]=EX(X[B+2]); X[B+3]=EX(X[B+3]); PIN(X); EXTRA; SBAR(); }while(0)
  #define BRD(g) (*(lds_cf4*)(cbn_+((g)&3)*32+((g)>>2)*128))
  #define BCP(X,B,c) do{ X[B]=qm-c[0]; X[B+1]=qm-c[1]; X[B+2]=qm-c[2]; X[B+3]=qm-c[3]; PIN(X); }while(0)
  #define VRD(i) do{ vlo[i]=vtr(vp_+(((i)>>2)*4096+((i)&3)*1024)); vhi[i]=vtr(vp_+(((i)>>2)*4096+((i)&3)*1024+512)); }while(0)
  #define KRD(G,j) do{ if(G){ kload2(kf,kp0+sl_next,j); SBAR(); } }while(0)
  #define STEP(C0,C1,P0,P1,t,GK,GV,GL) do{ SBAR(); \
    const lds_cptr vp_=vp0+sl_prev; \
    VRD(0); SBAR(); float sacc=(P0[0]+P0[1]); \
    GAPA(C0=__builtin_amdgcn_mfma_f32_32x32x16_bf16(kf[0],qr[0],C0,0,0,0), P0[2],P0[3],P0[4],P0[5],     pw0[0]=PKW(P0,0), pw0[1]=PKW(P0,2), pw0); \
    VRD(4); SBAR(); GAPA(C1=__builtin_amdgcn_mfma_f32_32x32x16_bf16(kf[1],qr[0],C1,0,0,0), P0[6],P0[7],P0[8],P0[9],     pw0[2]=PKW(P0,4), pw0[3]=PKW(P0,6), pw0); \
    VRD(1); SBAR(); GAPA(C0=__builtin_amdgcn_mfma_f32_32x32x16_bf16(kf[2],qr[1],C0,0,0,0),   P0[10],P0[11],P0[12],P0[13], pw1[0]=PKW(P0,8), pw1[1]=PKW(P0,10), pw1); \
    VRD(5); SBAR(); GAPA(C1=__builtin_amdgcn_mfma_f32_32x32x16_bf16(kf[3],qr[1],C1,0,0,0),   P0[14],P0[15],P1[0],P1[1],   pw1[2]=PKW(P0,12),pw1[3]=PKW(P0,14), pw1); \
    VRD(2); SBAR(); GAPA(C0=__builtin_amdgcn_mfma_f32_32x32x16_bf16(kf[4],qr[2],C0,0,0,0),   P1[2],P1[3],P1[4],P1[5],     pw2[0]=PKW(P1,0), pw2[1]=PKW(P1,2), pw2); \
    VRD(6); SBAR(); GAPA(C1=__builtin_amdgcn_mfma_f32_32x32x16_bf16(kf[5],qr[2],C1,0,0,0),   P1[6],P1[7],P1[8],P1[9],     pw2[2]=PKW(P1,4), pw2[3]=PKW(P1,6), pw2); \
    VRD(3); SBAR(); GAPA(C0=__builtin_amdgcn_mfma_f32_32x32x16_bf16(kf[6],qr[3],C0,0,0,0),   P1[10],P1[11],P1[12],P1[13], pw3[0]=PKW(P1,8), pw3[1]=PKW(P1,10), pw3); \
    VRD(7); SBAR(); GAPA(C1=__builtin_amdgcn_mfma_f32_32x32x16_bf16(kf[7],qr[3],C1,0,0,0),   P1[14],P1[15],0.f,0.f,       pw3[2]=PKW(P1,12),pw3[3]=PKW(P1,14), pw3); \
    l_reg+=sacc; \
    if(GK){DMA_K((t)+3,sl_cur);} if(GV){DMA_V((t)+1,sl_next);} \
    CMASK(C0,C1,t); \
    { float a=MX3(C0[0],C0[1],C1[0]),b=MX3(C0[2],C0[3],C1[1]); a=MX3(a,C1[2],C1[3]); \
      _Pragma("unroll") for(int r=4;r<16;r+=4){a=MX3(a,C0[r],C0[r+1]);b=MX3(b,C0[r+2],C0[r+3]);a=MX3(a,C1[r],C1[r+1]);b=MX3(b,C1[r+2],C1[r+3]);} \
      float rm=__builtin_fmaxf(a,b); { auto rr=__builtin_amdgcn_permlane32_swap(__float_as_uint(rm),__float_as_uint(rm),false,false); rm=__builtin_fmaxf(__uint_as_float(rr[0]),__uint_as_float(rr[1])); } \
      resc=false; \
      if(__builtin_expect(__any(rm>(float)THRL),0)){ const float dl=__builtin_fmaxf(rm,0.f); mhat+=dl; \
        _Pragma("unroll") for(int r=0;r<16;++r){C0[r]-=dl;C1[r]-=dl;} \
        qm-=dl; \
        const float f=__builtin_amdgcn_exp2f(-dl); l_reg*=f; if(hi==0)wsf[r32]=f; resc=true; } } \
    const lds_cptr cbn_=cum3+((t)+1)*256; f32x4v ca_; if(GL){ca_=BRD(0);} \
    SBAR(); \
    GAPB(o[0]=__builtin_amdgcn_mfma_f32_32x32x16_bf16(PAF(0),VFR(0),o[0],0,0,0), C0,0, if(GL){BCP(P0,0,ca_);ca_=BRD(1);}); \
    GAPB(o[1]=__builtin_amdgcn_mfma_f32_32x32x16_bf16(PAF(0),VFR(4),o[1],0,0,0), C0,4, if(GL){BCP(P0,4,ca_);ca_=BRD(2);}); \
    KRD(GL,0); GAPB(o[0]=__builtin_amdgcn_mfma_f32_32x32x16_bf16(PAF(1),VFR(1),o[0],0,0,0), C0,8, if(GL){BCP(P0,8,ca_);ca_=BRD(3);}); \
    KRD(GL,1); GAPB(o[1]=__builtin_amdgcn_mfma_f32_32x32x16_bf16(PAF(1),VFR(5),o[1],0,0,0), C0,12, if(GL){BCP(P0,12,ca_);ca_=BRD(4);}); \
    KRD(GL,2); GAPB(o[0]=__builtin_amdgcn_mfma_f32_32x32x16_bf16(PAF(2),VFR(2),o[0],0,0,0), C1,0, if(GL){BCP(P1,0,ca_);ca_=BRD(5);}); \
    KRD(GL,3); GAPB(o[1]=__builtin_amdgcn_mfma_f32_32x32x16_bf16(PAF(2),VFR(6),o[1],0,0,0), C1,4, if(GL){BCP(P1,4,ca_);ca_=BRD(6);}); \
    GAPB(o[0]=__builtin_amdgcn_mfma_f32_32x32x16_bf16(PAF(3),VFR(3),o[0],0,0,0), C1,8, if(GL){BCP(P1,8,ca_);ca_=BRD(7);}); \
    GAPB(o[1]=__builtin_amdgcn_mfma_f32_32x32x16_bf16(PAF(3),VFR(7),o[1],0,0,0), C1,12, if(GL){BCP(P1,12,ca_);}); \
    }while(0)
  int t=1;
  #undef CMASK
  #define CMASK(P0,P1,t) do{}while(0)
  for(;t+5<NT;t+=2){
    STEP(pB0,pB1,pA0,pA1,t,true,true,true);     WAIT_BAR(2); RESC(); ROT();
    STEP(pA0,pA1,pB0,pB1,t+1,true,true,true);   WAIT_BAR(2); RESC(); ROT();
  }
  #undef CMASK
  #define CMASK(P0,P1,t) do{int jb_=(t)-(NT-4); if(jb_>=0)cmask(P0,P1,jb_,qrel,hi);}while(0)
  #define ENDW(tt) do{ if((tt)+3<NT){WAIT_BAR(2);} else if((tt)+2<NT){WAIT_BAR(1);} else {WAIT_BAR(0);} }while(0)
  for(;t+1<NT;t+=2){
    STEP(pB0,pB1,pA0,pA1,t,(t+3<NT),(t+1<NT),(t+1<NT));       ENDW(t);   RESC(); ROT();
    STEP(pA0,pA1,pB0,pB1,t+1,(t+4<NT),(t+2<NT),(t+2<NT));     ENDW(t+1); RESC(); ROT();
  }
  STEP(pB0,pB1,pA0,pA1,NT-1,false,false,false); RESC();
  { float sacc=pB0[0]+pB0[1]; _Pragma("unroll") for(int r=2;r<16;++r)sacc+=pB0[r]; _Pragma("unroll") for(int r=0;r<16;++r)sacc+=pB1[r]; l_reg+=sacc;
    pw0=(u32x4){PKW(pB0,0),PKW(pB0,2),PKW(pB0,4),PKW(pB0,6)};pw1=(u32x4){PKW(pB0,8),PKW(pB0,10),PKW(pB0,12),PKW(pB0,14)};pw2=(u32x4){PKW(pB1,0),PKW(pB1,2),PKW(pB1,4),PKW(pB1,6)};pw3=(u32x4){PKW(pB1,8),PKW(pB1,10),PKW(pB1,12),PKW(pB1,14)};
    SBAR(); pv(o,vb0+sl_cur,PAF(0),PAF(1),PAF(2),PAF(3)); }
  #undef PKW
  #undef PAF
  #undef VFR
  #undef PIN
  #undef MX3
  #undef GAPA
  #undef GAPB
  #undef BRD
  #undef BCP
  #undef BIAS
  #undef EX
  #undef VRD
  #undef KRD
  #undef STEP
  #undef ENDW
  {auto rr=__builtin_amdgcn_permlane32_swap(__float_as_uint(l_reg),__float_as_uint(l_reg),false,false);l_reg=__uint_as_float(rr[0])+__uint_as_float(rr[1]);}
  if(hi==0)wsf[32+r32]=l_reg;asm volatile("s_waitcnt lgkmcnt(0)":::"memory");
  float rli[16];
  #pragma unroll
  for(int r=0;r<16;++r)rli[r]=__builtin_amdgcn_rcpf(wsf[32+crow(r,hi)]);
  bf16*Ow=O+(rowbase+q0+wid*QBLK)*PO+h*D;
  { bf16*stg=(bf16*)(shm+LDS_OST)+wid*2048;
    #pragma unroll
    for(int r=0;r<16;++r){const int orow=crow(r,hi);
      #pragma unroll
      for(int d0=0;d0<2;++d0)stg[orow*64+d0*32+r32]=__float2bfloat16(o[d0][r]*rli[r]);}
    asm volatile("s_waitcnt lgkmcnt(0)":::"memory");
    #pragma unroll
    for(int i=0;i<4;++i){const int row=i*8+(lane>>3),ch=lane&7; const u32x4 v=*(const u32x4*)(stg+row*64+ch*8); ATTN_STORE16(Ow+(long)row*PO+ch*8,v);} }
  asm volatile("s_waitcnt lgkmcnt(0)\n\ts_barrier":::"memory");
  #undef DMA_K
  #undef DMA_V
  #undef CMASK
  #undef START
  #undef RESC
  #undef ROT
}
constexpr int ATTN_LDS_BYTES=LDS_BYTES+16;
struct AttnTensors { const bf16* Q; const bf16* K; const bf16* V; bf16* O; const float* cum; const float* qk2; unsigned* queue; };
template<int THRL=8> __device__ __forceinline__ void attn_phase(char*lds,const AttnTensors&T){
  const int tid=threadIdx.x; __attribute__((address_space(3))) unsigned* qw=(__attribute__((address_space(3))) unsigned*)((__attribute__((address_space(3))) char*)lds+LDS_BYTES);
  for(;;){
    if(tid==0){ qw[0]=__hip_atomic_fetch_add(T.queue,1u,__ATOMIC_RELAXED,__HIP_MEMORY_SCOPE_AGENT); }
    __syncthreads();
    const int u=__builtin_amdgcn_readfirstlane((int)qw[0]);
    if(u>=BATCH*NHEAD*NQB)break;
    const int bh=u&(BATCH*NHEAD-1), qb=NQB-1-(u>>5), q0=qb*QB; const float*cumG=T.cum+(long)bh*SEQ;
    float qn=0.f,kn=0.f;
    #pragma unroll
    for(int pp=0;pp<8;++pp){qn=fmaxf(qn,T.qk2[16*bh+2*pp]);kn=fmaxf(kn,T.qk2[16*bh+2*pp+1]);}
    const float th=-(2.f*sqrtf(qn*kn)+40.f);
    const int lane=tid&63; const bool ok=(lane<4*qb)&&(cumG[q0]-cumG[64*lane+63]>=th);
    const unsigned long long mk=__ballot(ok); int t0=mk?(int)__builtin_ctzll(mk):4*qb; t0&=~1; t0=__builtin_amdgcn_readfirstlane(t0);
    attn_unit<THRL>(bh/NHEAD,bh%NHEAD,qb,T.Q,T.K,T.V,T.O,cumG,t0,lds);
  }
}
#undef SBAR
#undef WAIT_BAR
}
#ifndef MK_FP8
#define MK_FP8 1
#endif
constexpr int NWAVES = 8, NTHR = 512;
constexpr int BATCH = 4, SEQ = 4096, DMODEL = 1024, MTOK = BATCH * SEQ;
constexpr int NQKV = 3072, INCOLS = 3096, DFF = 2816, NEXP = 8;
constexpr float EPS = 1e-6f, LOG2E = 1.4426950408889634f;
constexpr size_t MiB = 1u << 20;
constexpr size_t WS_CTL = 0, CTL_ZERO_BYTES = 1 * MiB;
constexpr size_t WS_MOD = 1 * MiB;
constexpr size_t WS_WSK = WS_MOD + 256 * 1024;
constexpr size_t WS_AL = WS_WSK + 128 * 1024;
constexpr size_t WS_ROUTE = 2 * MiB;
constexpr size_t WS_ROWTOK = 3 * MiB;
constexpr size_t WS_CUM = 4 * MiB;
constexpr size_t WS_FFGLR = 5 * MiB;
constexpr size_t WS_GLAEB = 7 * MiB;
constexpr size_t WS_QK2P = 7 * MiB + 512 * 1024;
constexpr size_t WS_WIN0 = 8 * MiB, WS_WO0 = 14 * MiB, WS_WGU0 = 16 * MiB, WS_WD0 = 27 * MiB;
constexpr size_t WS_WIN1 = 33 * MiB, WS_WGLU = 35 * MiB, WS_WO1 = 37 * MiB, WS_S5T = 39 * MiB, WS_S5WA = 79 * MiB;
constexpr size_t WS_H3 = 8 * MiB;
constexpr size_t WS_WEGU = 95 * MiB, WS_WED = 183 * MiB;
constexpr size_t WS_YPERM = 95 * MiB;
constexpr size_t WS_YPERM2 = 8 * MiB;
constexpr size_t WS_BIG = 227 * MiB;
constexpr size_t WS_QKV = WS_BIG, WS_MIX = WS_BIG + 96 * MiB, WS_H = WS_BIG + 128 * MiB;
constexpr size_t WS_GLAB = WS_BIG + 160 * MiB;
constexpr size_t WS_ACT = WS_BIG;
constexpr size_t WS_AU = WS_BIG, WS_E = WS_BIG + 40 * MiB, WS_YG = WS_BIG + 56 * MiB, WS_Z = WS_BIG + 88 * MiB;
constexpr size_t WS_ACTP = WS_BIG;
constexpr size_t WS_END = 414 * MiB;
constexpr int MAXPROWS = 34816;
constexpr int CW_TMO = 0, CW_CODE = 1, CW_BAR = 4096, CW_ECNT = 8192;
constexpr int CW_AQ = 9216, CW_QK2 = 9280;
constexpr int RING_BYTES = 131072, GTAB_OFF = RING_BYTES, GTAB_BYTES = 16384, MISC_OFF = GTAB_OFF + GTAB_BYTES, LDS_BYTES = MISC_OFF + 1024;

typedef GAS unsigned gu32;
#define RLX_AGENT __ATOMIC_RELAXED, __HIP_MEMORY_SCOPE_AGENT
#define LDS_WAIT() asm volatile("s_waitcnt lgkmcnt(0)" ::: "memory")
#define VM_WAIT() asm volatile("s_waitcnt vmcnt(0)" ::: "memory")
#define LDS_BAR() asm volatile("s_waitcnt lgkmcnt(0)\n\ts_barrier" ::: "memory")

#define XB_TMO      128
#define XB_XCNT(j)  (256  + 64 * (j))
#define XB_XSUB(j)  (1280 + 64 * (j))
#define XB_XGEN(j)  (2304 + 64 * (j))
#define XB_TOP      3328
#define XB_TOPGEN   3392
#define XCD_BAR_WORDS 3456
#define XB_SPIN_CAP (1u << 18)
__device__ __forceinline__ unsigned xb_ld(unsigned* p)              { return __hip_atomic_load(p, __ATOMIC_RELAXED, __HIP_MEMORY_SCOPE_AGENT); }
__device__ __forceinline__ unsigned xb_add(unsigned* p, unsigned v) { return __hip_atomic_fetch_add(p, v, __ATOMIC_RELAXED, __HIP_MEMORY_SCOPE_AGENT); }
__device__ __forceinline__ unsigned xb_xcc_id() { return (unsigned)__builtin_amdgcn_s_getreg((3 << 11) | 20) & 0xFu; }
#define XB_SPIN(cond, bar) do { unsigned _sp = 0; while (cond) { __builtin_amdgcn_s_sleep(1); \
    if ((++_sp & 255u) == 0u) { if (xb_ld(&(bar)[XB_TMO])) break; if (_sp > XB_SPIN_CAP) { atomicAdd(&(bar)[XB_TMO], 1u); break; } } } } while (0)
struct XcdBarrier { unsigned* bar; unsigned x; volatile LAS unsigned* st; };
__device__ __forceinline__ XcdBarrier xcd_barrier_post(unsigned* bar, volatile LAS unsigned* st) {
    XcdBarrier b; b.bar = bar; b.x = xb_xcc_id(); b.st = st;
    if (threadIdx.x == 0) (void)xb_add(&bar[XB_XCNT(b.x)], 1u);
    return b;
}
__device__ __forceinline__ void xcd_barrier_complete(unsigned* bar, unsigned x, unsigned& nloc, unsigned& nx) {
    const unsigned G = gridDim.x * gridDim.y * gridDim.z;
    unsigned sum, cnt, mine, sp = 0u;
    for (;;) {
        sum = 0u; cnt = 0u; mine = 0u;
#pragma unroll
        for (unsigned j = 0; j < 16; ++j) { const unsigned c = xb_ld(&bar[XB_XCNT(j)]); sum += c; cnt += (c > 0u) ? 1u : 0u; mine = (j == x) ? c : mine; }
        if (sum == G) break;
        __builtin_amdgcn_s_sleep(1);
        if ((++sp & 255u) == 0u) { if (xb_ld(&bar[XB_TMO])) break; if (sp > XB_SPIN_CAP) { atomicAdd(&bar[XB_TMO], 1u); break; } }
    }
    nloc = mine > 0u ? mine : 1u; nx = cnt > 0u ? cnt : 1u;
}
__device__ __forceinline__ void xcd_barrier(const XcdBarrier& b) {
    asm volatile("s_waitcnt vmcnt(0)" ::: "memory");
    __syncthreads();
    if (threadIdx.x == 0) {
        unsigned* bar = b.bar;
        __builtin_amdgcn_s_waitcnt(0);
        unsigned nloc = b.st[0], nx = b.st[1];
        if (nloc == 0u) { xcd_barrier_complete(bar, b.x, nloc, nx); b.st[0] = nloc; b.st[1] = nx; }
        const unsigned old = xb_add(&bar[XB_XSUB(b.x)], 1u);
        const unsigned gen = old / nloc;
        if (old + 1u == (gen + 1u) * nloc) {
            __builtin_amdgcn_fence(__ATOMIC_RELEASE, "agent");
            asm volatile("s_waitcnt vmcnt(0)" ::: "memory");
            const unsigned og = xb_add(&bar[XB_TOP], 1u);
            const unsigned tg = og / nx;
            if (og + 1u == (tg + 1u) * nx) xb_add(&bar[XB_TOPGEN], 1u);
            else XB_SPIN(xb_ld(&bar[XB_TOPGEN]) == tg, bar);
            __builtin_amdgcn_fence(__ATOMIC_ACQUIRE, "agent");
            xb_add(&bar[XB_XGEN(b.x)], 1u);
            asm volatile("s_waitcnt vmcnt(0)" ::: "memory");
        } else {
            XB_SPIN(xb_ld(&bar[XB_XGEN(b.x)]) == gen, bar);
            __builtin_amdgcn_fence(__ATOMIC_ACQUIRE, "agent");
            asm volatile("s_waitcnt vmcnt(0)" ::: "memory");
        }
    }
    __syncthreads();
}

struct Frame {
    LAS unsigned char* lds;
    gu32* ctl;
    int tid, lane, wave, vcu, G;
    const float* const* in; float* out; unsigned char* ws;
};
__device__ __forceinline__ float wave_sum(float v) {
#pragma unroll
    for (int o = 1; o < 64; o <<= 1) v += __shfl_xor(v, o);
    return v;
}
__device__ __forceinline__ unsigned f2bf(float f) { unsigned u = __builtin_bit_cast(unsigned, f); return (u + 0x7fffu + ((u >> 16) & 1u)) >> 16; }
__device__ __forceinline__ unsigned pk2(float lo, float hi) { return f2bf(lo) | (f2bf(hi) << 16); }
__device__ __forceinline__ float log_sigmoid_f(float x) { return fminf(x, 0.f) - log1pf(expf(-fabsf(x))); }
struct TrDesc { const float* src; bf16_t* dst; int ldw, K, f8; };
__device__ __forceinline__ void tr_seg(const float* W, int ldw, int col0, int ncols, int K, bf16_t* WT, int mode, int rowoff, int item, int lane, TrDesc& D, int f8 = 0) {
    const int nblk = ncols >> 6, kb = item / nblk, nb = item - kb * nblk, n0 = nb * 64;
    const int drow = mode ? (((n0 >> 7) << 8) + (n0 & 127) + rowoff) : (rowoff + n0);
    D.src = W + (size_t)(kb * 64 + (lane >> 4)) * ldw + col0 + n0 + (lane & 15) * 4; D.dst = f8 ? (bf16_t*)((unsigned char*)WT + (size_t)drow * K + kb * 64) : WT + (size_t)drow * K + kb * 64; D.ldw = ldw; D.K = K; D.f8 = f8;
}
constexpr int TR_I_WIN = 384, TR_I_SQ = 256, TR_I_FF = 704;
constexpr int TR_NITEMS = 2 * TR_I_WIN + TR_I_SQ + 3 * TR_I_FF + 3 * TR_I_SQ + 24 * TR_I_FF;
__device__ __forceinline__ void tr_decode(Frame& F, int it, TrDesc& D) {
    unsigned char* ws = F.ws; const int lane = F.lane; int r = it;
    if (r < TR_I_WIN) { tr_seg(F.in[5], INCOLS, 0, 1536, 1024, (bf16_t*)(ws + WS_WIN0), 0, 0, r, lane, D); return; } r -= TR_I_WIN;
    if (r < TR_I_WIN) { tr_seg(F.in[5], INCOLS, 1544, 1536, 1024, (bf16_t*)(ws + WS_WIN0), 0, 1536, r, lane, D); return; } r -= TR_I_WIN;
    if (r < TR_I_SQ) { tr_seg(F.in[10], 1024, 0, 1024, 1024, (bf16_t*)(ws + WS_WO0), 0, 0, r, lane, D); return; } r -= TR_I_SQ;
    if (r < TR_I_FF) { tr_seg(F.in[14], DFF, 0, DFF, 1024, (bf16_t*)(ws + WS_WGU0), 1, 0, r, lane, D, MK_FP8); return; } r -= TR_I_FF;
    if (r < TR_I_FF) { tr_seg(F.in[15], DFF, 0, DFF, 1024, (bf16_t*)(ws + WS_WGU0), 1, 128, r, lane, D, MK_FP8); return; } r -= TR_I_FF;
    if (r < TR_I_FF) { tr_seg(F.in[16], 1024, 0, 1024, DFF, (bf16_t*)(ws + WS_WD0), 0, 0, r, lane, D); return; } r -= TR_I_FF;
    if (r < TR_I_SQ) { tr_seg(F.in[20], 1024, 0, 1024, 1024, (bf16_t*)(ws + WS_WIN1), 0, 0, r, lane, D); return; } r -= TR_I_SQ;
    if (r < TR_I_SQ) { tr_seg(F.in[29], 1024, 0, 1024, 1024, (bf16_t*)(ws + WS_WGLU), 0, 0, r, lane, D); return; } r -= TR_I_SQ;
    if (r < TR_I_SQ) { tr_seg(F.in[30], 1024, 0, 1024, 1024, (bf16_t*)(ws + WS_WO1), 0, 0, r, lane, D); return; } r -= TR_I_SQ;
    const int idx = r / TR_I_FF, ri = r - idx * TR_I_FF, e = idx / 3, kind = idx - e * 3;
    if (kind == 0) tr_seg(F.in[35] + (size_t)e * 1024 * DFF, DFF, 0, DFF, 1024, (bf16_t*)((unsigned char*)(ws + WS_WEGU) + (size_t)e * 5632 * 1024 * (MK_FP8 ? 1 : 2)), 1, 0, ri, lane, D, MK_FP8);
    else if (kind == 1) tr_seg(F.in[36] + (size_t)e * 1024 * DFF, DFF, 0, DFF, 1024, (bf16_t*)((unsigned char*)(ws + WS_WEGU) + (size_t)e * 5632 * 1024 * (MK_FP8 ? 1 : 2)), 1, 128, ri, lane, D, MK_FP8);
    else tr_seg(F.in[37] + (size_t)e * DFF * 1024, 1024, 0, 1024, DFF, (bf16_t*)(ws + WS_WED) + (size_t)e * 1024 * DFF, 0, 0, ri, lane, D);
}
__device__ __forceinline__ void tr_load(const TrDesc& D, f32x4 (&v)[16]) {
#pragma unroll
    for (int i = 0; i < 16; ++i) v[i] = __builtin_nontemporal_load((const f32x4*)(D.src + (size_t)(4 * i) * D.ldw));
}
__device__ __forceinline__ void tr_store(const TrDesc& D, const f32x4 (&v)[16], LAS float* scr, int lane) {
    const int rq = lane >> 4, c4 = (lane & 15) * 4;
#pragma unroll
    for (int i = 0; i < 16; ++i) { LAS float* d = scr + (4 * i + rq) * 65 + c4; d[0] = v[i].x; d[1] = v[i].y; d[2] = v[i].z; d[3] = v[i].w; }
    LDS_WAIT(); asm volatile("" ::: "memory");
    if (D.f8) {
        const int c = lane & 3; unsigned char* dst8 = (unsigned char*)D.dst;
#pragma unroll
        for (int j = 0; j < 4; ++j) { const int n = (lane >> 2) + 16 * j; const LAS float* s = scr + (16 * c) * 65 + n; const float sc = FP8_W_SCALE;
            u32x4 o; o.x = cvt4_fp8(s[0 * 65] * sc, s[1 * 65] * sc, s[2 * 65] * sc, s[3 * 65] * sc); o.y = cvt4_fp8(s[4 * 65] * sc, s[5 * 65] * sc, s[6 * 65] * sc, s[7 * 65] * sc);
            o.z = cvt4_fp8(s[8 * 65] * sc, s[9 * 65] * sc, s[10 * 65] * sc, s[11 * 65] * sc); o.w = cvt4_fp8(s[12 * 65] * sc, s[13 * 65] * sc, s[14 * 65] * sc, s[15 * 65] * sc);
            *(GAS u32x4*)(dst8 + (size_t)n * D.K + 16 * c) = o; }
    } else {
        const int c = lane & 7;
#pragma unroll
        for (int j = 0; j < 8; ++j) { const int n = (lane >> 3) + 8 * j; const LAS float* s = scr + (8 * c) * 65 + n;
            u32x4 o; o.x = pk2(s[0 * 65], s[1 * 65]); o.y = pk2(s[2 * 65], s[3 * 65]); o.z = pk2(s[4 * 65], s[5 * 65]); o.w = pk2(s[6 * 65], s[7 * 65]);
            *(GAS u32x4*)(D.dst + (size_t)n * D.K + 8 * c) = o; }
    }
    LDS_WAIT(); asm volatile("" ::: "memory");
}
__device__ __forceinline__ void p0_transposes(Frame& F) {
    LAS float* scr = (LAS float*)(F.lds + F.wave * 16896);
    const int gw = F.vcu * NWAVES + F.wave, NGW = F.G * NWAVES;
    int it = gw; if (it >= TR_NITEMS) return;
    TrDesc Da, Db; f32x4 va[16], vb[16];
    tr_decode(F, it, Da); tr_load(Da, va);
    for (;;) {
        int nx = it + NGW; const bool m1 = nx < TR_NITEMS;
        if (m1) { tr_decode(F, nx, Db); tr_load(Db, vb); }
        tr_store(Da, va, scr, F.lane);
        if (!m1) break;
        it = nx; nx = it + NGW; const bool m2 = nx < TR_NITEMS;
        if (m2) { tr_decode(F, nx, Da); tr_load(Da, va); }
        tr_store(Db, vb, scr, F.lane);
        if (!m2) break;
        it = nx;
    }
}
__device__ __forceinline__ void sincos_rev(double ang, float& cs, float& sn) {
    const double rev = ang * 0.15915494309189535; const float fr = (float)(rev - __builtin_rint(rev));
    cs = __builtin_amdgcn_cosf(fr); sn = __builtin_amdgcn_sinf(fr);
}
__device__ __forceinline__ void p0_mod_job(Frame& F, int job) {
    const int s = job / 48, cg = job - s * 48;
    const float* W = s == 0 ? F.in[3] : s == 1 ? F.in[12] : s == 2 ? F.in[18] : F.in[32]; const float* bias = s == 0 ? F.in[4] : s == 1 ? F.in[13] : s == 2 ? F.in[19] : F.in[33];
    LAS float* sc = (LAS float*)F.lds;
    LAS float* part = sc + 4096;
    for (int i = F.tid; i < 4096; i += NTHR) { const float v = F.in[1][i]; sc[i] = v / (1.f + expf(-v)); }
    __syncthreads();
    const int col = cg * 64 + F.lane; float a0 = 0.f, a1 = 0.f, a2 = 0.f, a3 = 0.f;
    const float* wp = W + (size_t)(F.wave * 128) * 3072 + col;
    for (int k0 = 0; k0 < 128; k0 += 32) { float wv[32];
#pragma unroll
        for (int k = 0; k < 32; ++k) wv[k] = wp[(size_t)(k0 + k) * 3072];
#pragma unroll
        for (int k = 0; k < 32; ++k) { const int kk = F.wave * 128 + k0 + k; a0 += sc[kk] * wv[k]; a1 += sc[1024 + kk] * wv[k]; a2 += sc[2048 + kk] * wv[k]; a3 += sc[3072 + kk] * wv[k]; } }
    part[(F.wave * 4 + 0) * 64 + F.lane] = a0; part[(F.wave * 4 + 1) * 64 + F.lane] = a1; part[(F.wave * 4 + 2) * 64 + F.lane] = a2; part[(F.wave * 4 + 3) * 64 + F.lane] = a3;
    __syncthreads();
    if (F.tid < 256) { const int b = F.tid >> 6, l = F.tid & 63; float t = bias[cg * 64 + l];
#pragma unroll
        for (int w = 0; w < 8; ++w) t += part[(w * 4 + b) * 64 + l];
        ((float*)(F.ws + WS_MOD))[(size_t)(s * 4 + b) * 3072 + cg * 64 + l] = t; }
    __syncthreads();
}
__device__ __forceinline__ void p0_s5_job(Frame& F, int job) {
    const int g = job >> 2, qd = job & 3, tid = F.tid;
    LAS float* L = (LAS float*)F.lds;
    LAS float* bbr = L;
    LAS float* bbi = L + 1024;
    LAS float* cr = L + 2048;
    LAS float* ci = L + 3072;
    LAS float* pwr = L + 4096;
    LAS float* pwi = pwr + 64 * 34;
    LAS float* Kt = pwi + 64 * 34;
    const float* lam_re = F.in[21] + g * 64; const float* lam_im = F.in[22] + g * 64; const float dt = expf(F.in[23][g]);
    const float* b_re = F.in[24] + (size_t)g * 1024; const float* b_im = F.in[25] + (size_t)g * 1024;
    const float* c_re = F.in[26] + (size_t)g * 1024; const float* c_im = F.in[27] + (size_t)g * 1024;
    for (int i = tid; i < 1024; i += NTHR) { cr[i] = c_re[i]; ci[i] = c_im[i]; }
    for (int i = tid; i < 64 * 33; i += NTHR) { const int p = i / 33, tau = i - p * 33; const float lr = lam_re[p], li = lam_im[p];
        const float mg = expf((float)tau * lr * dt); float cs, sn; sincos_rev((double)tau * (double)li * (double)dt, cs, sn); pwr[p * 34 + tau] = mg * cs; pwi[p * 34 + tau] = mg * sn; }
    for (int i = tid; i < 1024; i += NTHR) { const int p = i >> 4; const float lr = lam_re[p], li = lam_im[p];
        float cs, sn; sincos_rev((double)li * (double)dt, cs, sn);
        const float mg = expf(lr * dt), ar = mg * cs, ai = mg * sn, den = lr * lr + li * li, nr = ar - 1.f, ni = ai;
        const float fr = (nr * lr + ni * li) / den, fi = (ni * lr - nr * li) / den; const float br = b_re[i], bi = b_im[i];
        bbr[i] = fr * br - fi * bi; bbi[i] = fr * bi + fi * br; }
    __syncthreads();
    {
        const int tl = tid >> 6, k = (tid >> 2) & 15, kq = (tid & 3) * 4, tau = 8 * qd + tl; float a0 = 0.f, a1 = 0.f, a2 = 0.f, a3 = 0.f;
        for (int p = 0; p < 64; ++p) { const float c_r = cr[k * 64 + p], c_i = ci[k * 64 + p], w_r = pwr[p * 34 + tau], w_i = pwi[p * 34 + tau];
            const float m_r = c_r * w_r - c_i * w_i, m_i = c_r * w_i + c_i * w_r;
            const f32x4 br = *(const LAS f32x4*)(bbr + p * 16 + kq), bi = *(const LAS f32x4*)(bbi + p * 16 + kq);
            a0 += m_r * br.x - m_i * bi.x; a1 += m_r * br.y - m_i * bi.y; a2 += m_r * br.z - m_i * bi.z; a3 += m_r * br.w - m_i * bi.w; }
        *(LAS f32x4*)(Kt + tl * 256 + k * 16 + kq) = (f32x4){a0, a1, a2, a3};
    }
    __syncthreads();
    bf16_t* T = (bf16_t*)(F.ws + WS_S5T) + (size_t)g * 512 * 640;
    for (int idx = tid; idx < 32 * 8 * 32; idx += NTHR) {
        const int hf = idx & 1, k = (idx >> 1) & 15, tl = (idx >> 5) & 7, i = idx >> 8, j = i - 8 * qd - tl;
        if (j >= 0) { const LAS float* kp = Kt + tl * 256 + k * 16 + hf * 8;
            u32x4 o; o.x = pk2(kp[0], kp[1]); o.y = pk2(kp[2], kp[3]); o.z = pk2(kp[4], kp[5]); o.w = pk2(kp[6], kp[7]);
            *(GAS u32x4*)(T + (size_t)(i * 16 + k) * 640 + j * 16 + hf * 8) = o; } }
    for (int ch = tid; ch < 128 * 80; ch += NTHR) {
        const int rl = ch / 80, c8 = (ch - rl * 80) * 8, n = qd * 128 + rl, i = n >> 4, k = n & 15; float v[8];
        if (c8 < 512) { if ((c8 >> 4) <= i) continue;
#pragma unroll
            for (int q = 0; q < 8; ++q) v[q] = 0.f;
        } else { const int sidx = c8 - 512, im = sidx >> 6, p0 = sidx & 63;
#pragma unroll
            for (int q = 0; q < 8; ++q) { const int p = p0 + q; const float c_r = cr[k * 64 + p], c_i = ci[k * 64 + p], w_r = pwr[p * 34 + i + 1], w_i = pwi[p * 34 + i + 1];
                v[q] = im ? -(c_r * w_i + c_i * w_r) : (c_r * w_r - c_i * w_i); } }
        u32x4 o; o.x = pk2(v[0], v[1]); o.y = pk2(v[2], v[3]); o.z = pk2(v[4], v[5]); o.w = pk2(v[6], v[7]);
        *(GAS u32x4*)(T + (size_t)n * 640 + c8) = o; }
    bf16_t* WA = (bf16_t*)(F.ws + WS_S5WA) + (size_t)g * 256 * 512;
    for (int ch = tid; ch < 64 * 64; ch += NTHR) {
        const int rl = ch >> 6, c8 = (ch & 63) * 8, n = qd * 64 + rl, j = c8 >> 4, k0 = c8 & 15; float v[8];
        if (n < 128) { const int im = n >> 6, p = n & 63; const float w_r = pwr[p * 34 + 31 - j], w_i = pwi[p * 34 + 31 - j];
#pragma unroll
            for (int q = 0; q < 8; ++q) { const float b_r = bbr[p * 16 + k0 + q], b_i = bbi[p * 16 + k0 + q]; v[q] = im ? (w_r * b_i + w_i * b_r) : (w_r * b_r - w_i * b_i); }
        } else {
#pragma unroll
            for (int q = 0; q < 8; ++q) v[q] = 0.f; }
        u32x4 o; o.x = pk2(v[0], v[1]); o.y = pk2(v[2], v[3]); o.z = pk2(v[4], v[5]); o.w = pk2(v[6], v[7]);
        *(GAS u32x4*)(WA + (size_t)n * 512 + c8) = o; }
    if (qd == 0 && tid < 64) { float* al = (float*)(F.ws + WS_AL) + (size_t)(g * 64 + tid) * 2; al[0] = pwr[tid * 34 + 32]; al[1] = pwi[tid * 34 + 32]; }
    __syncthreads();
}
__device__ __forceinline__ void p0_prologue(Frame& F) {
    for (int job = blockIdx.x; job < 192; job += F.G) p0_mod_job(F, job);
    for (int job = blockIdx.x; job < 256; job += F.G) p0_s5_job(F, job);
    {
        float* wsk = (float*)(F.ws + WS_WSK);
        for (int i = blockIdx.x * NTHR + F.tid; i < 24 * 1024; i += F.G * NTHR) { const int c = i >> 10, k = i & 1023; wsk[i] = F.in[5][(size_t)k * INCOLS + (c < 8 ? 1536 + c : 3080 + c - 8)]; }
    }
    p0_transposes(F);
}
template <int MODE, bool F8OUT = false>
__device__ __forceinline__ void norm_mod_phase(Frame& F, const float* __restrict__ xsrc, const float* __restrict__ normw, const float* __restrict__ modv, bf16_t* __restrict__ hout) {
    LAS f32x2* tab = (LAS f32x2*)F.lds;
    LAS float* wx = (LAS float*)(F.lds + 32768);
    LAS int* wcnt = (LAS int*)(F.lds + 32768 + 98304);
    LAS int* wbase = wcnt + 64;
    for (int i = F.tid; i < 4096; i += NTHR) { const int b = i >> 10, c = i & 1023; tab[i] = (f32x2){normw[c] * (1.f + modv[b * 3072 + 1024 + c]), modv[b * 3072 + c]}; }
    if (MODE == 1) { const float* wsk = (const float*)(F.ws + WS_WSK); for (int i = F.tid; i < 24 * 1024; i += NTHR) wx[i] = wsk[i]; }
    if (MODE == 2) { const float* wr_ = F.in[34]; for (int i = F.tid; i < 8 * 1024; i += NTHR) { const int e = i >> 10, k = i & 1023; wx[i] = wr_[k * 8 + e]; } }
    __syncthreads();
    const int gw = F.vcu * NWAVES + F.wave, NGW = F.G * NWAVES, lane = F.lane;
    int cnt0 = 0, cnt1 = 0, cnt2 = 0, cnt3 = 0, cnt4 = 0, cnt5 = 0, cnt6 = 0, cnt7 = 0;
    unsigned* route = (unsigned*)(F.ws + WS_ROUTE);
    for (int m0 = gw; m0 < MTOK; m0 += 4 * NGW) {
        f32x4 v[4][4]; float rinv[4];
#pragma unroll
        for (int r = 0; r < 4; ++r) { const int m = m0 + r * NGW < MTOK ? m0 + r * NGW : m0; const GAS f32x4* xr = (const GAS f32x4*)(xsrc + (size_t)m * 1024) + lane;
#pragma unroll
            for (int j = 0; j < 4; ++j) v[r][j] = xr[64 * j]; }
#pragma unroll
        for (int r = 0; r < 4; ++r) { float ss = 0.f;
#pragma unroll
            for (int j = 0; j < 4; ++j) ss += (v[r][j].x * v[r][j].x + v[r][j].y * v[r][j].y) + (v[r][j].z * v[r][j].z + v[r][j].w * v[r][j].w);
            rinv[r] = 1.f / sqrtf(wave_sum(ss) * (1.f / 1024.f) + EPS); }
#pragma unroll
        for (int r = 0; r < 4; ++r) { const int m = m0 + r * NGW; const bool live = m < MTOK; const int b = (live ? m : m0) >> 12;
            GAS u32x2* o8 = (GAS u32x2*)(hout + (size_t)(live ? m : m0) * 1024) + lane; GAS unsigned* o4 = (GAS unsigned*)((GAS unsigned char*)hout + (size_t)(live ? m : m0) * 1024) + lane;
#pragma unroll
            for (int j = 0; j < 4; ++j) { const int c = 4 * lane + 256 * j; const LAS f32x2* tb = tab + b * 1024 + c;
                const f32x2 t0 = tb[0], t1 = tb[1], t2 = tb[2], t3 = tb[3];
                v[r][j].x = v[r][j].x * rinv[r] * t0.x + t0.y; v[r][j].y = v[r][j].y * rinv[r] * t1.x + t1.y; v[r][j].z = v[r][j].z * rinv[r] * t2.x + t2.y; v[r][j].w = v[r][j].w * rinv[r] * t3.x + t3.y;
                if (live) { if (F8OUT) o4[64 * j] = cvt4_fp8(v[r][j].x * FP8_ACT_SCALE, v[r][j].y * FP8_ACT_SCALE, v[r][j].z * FP8_ACT_SCALE, v[r][j].w * FP8_ACT_SCALE);
                    else o8[64 * j] = (u32x2){cvt_pk_bf16(v[r][j].x, v[r][j].y), cvt_pk_bf16(v[r][j].z, v[r][j].w)}; } } }
        if (MODE == 1) {
            float a[96];
#pragma unroll
            for (int c = 0; c < 24; ++c) { f32x4 w[4];
#pragma unroll
                for (int j = 0; j < 4; ++j) w[j] = *(const LAS f32x4*)(wx + c * 1024 + 4 * lane + 256 * j);
#pragma unroll
                for (int r = 0; r < 4; ++r) { f32x2 p2 = {0.f, 0.f};
#pragma unroll
                    for (int j = 0; j < 4; ++j) { p2 = __builtin_elementwise_fma((f32x2){v[r][j].x, v[r][j].y}, (f32x2){w[j].x, w[j].y}, p2); p2 = __builtin_elementwise_fma((f32x2){v[r][j].z, v[r][j].w}, (f32x2){w[j].z, w[j].w}, p2); }
                    a[r * 24 + c] = p2.x + p2.y; } }
#define RS_STEP(MSK, HALF) { const bool hi_ = (lane & (MSK)) != 0; _Pragma("unroll") for (int i = 0; i < (HALF); ++i) { const float keep_ = hi_ ? a[i + (HALF)] : a[i], send_ = hi_ ? a[i] : a[i + (HALF)]; a[i] = keep_ + __shfl_xor(send_, (MSK)); } }
            RS_STEP(32, 48) RS_STEP(16, 24) RS_STEP(8, 12) RS_STEP(4, 6) RS_STEP(2, 3)
#undef RS_STEP
#pragma unroll
            for (int i = 0; i < 3; ++i) a[i] += __shfl_xor(a[i], 1);
            if ((lane & 1) == 0) { float* fg = (float*)(F.ws + WS_FFGLR);
#pragma unroll
                for (int i = 0; i < 3; ++i) { const int id = 3 * (lane >> 1) + i, r = id / 24, c = id - r * 24, m = m0 + r * NGW; if (m < MTOK) fg[(size_t)m * 24 + c] = a[i]; } }
        }
        if (MODE == 2) {
#pragma unroll
            for (int r = 0; r < 4; ++r) { const int m = m0 + r * NGW; if (m >= MTOK) continue;
                float lg[8];
#pragma unroll
                for (int e = 0; e < 8; ++e) { float p = 0.f;
#pragma unroll
                    for (int j = 0; j < 4; ++j) { const f32x4 w = *(const LAS f32x4*)(wx + e * 1024 + 4 * lane + 256 * j); p += (v[r][j].x * w.x + v[r][j].y * w.y) + (v[r][j].z * w.z + v[r][j].w * w.w); }
                    lg[e] = wave_sum(p); }
                int e0 = 0; float v0 = lg[0];
#pragma unroll
                for (int e = 1; e < 8; ++e) if (lg[e] > v0) { v0 = lg[e]; e0 = e; }
                int e1 = -1; float v1 = -INFINITY;
#pragma unroll
                for (int e = 0; e < 8; ++e) if (e != e0 && lg[e] > v1) { v1 = lg[e]; e1 = e; }
                const float ex = expf(v1 - v0), w0 = 1.f / (1.f + ex), w1 = ex / (1.f + ex);
                if (lane == 0) { GAS u32x4* rp = (GAS u32x4*)(route + (size_t)m * 8); rp[0] = (u32x4){(unsigned)e0, (unsigned)e1, 0u, 0u}; rp[1] = (u32x4){__float_as_uint(w0), __float_as_uint(w1), 0u, 0u}; }
                cnt0 += (e0 == 0) + (e1 == 0); cnt1 += (e0 == 1) + (e1 == 1); cnt2 += (e0 == 2) + (e1 == 2); cnt3 += (e0 == 3) + (e1 == 3);
                cnt4 += (e0 == 4) + (e1 == 4); cnt5 += (e0 == 5) + (e1 == 5); cnt6 += (e0 == 6) + (e1 == 6); cnt7 += (e0 == 7) + (e1 == 7); }
        }
    }
    if (MODE == 2) {
        if (lane < 8) { const int c = lane == 0 ? cnt0 : lane == 1 ? cnt1 : lane == 2 ? cnt2 : lane == 3 ? cnt3 : lane == 4 ? cnt4 : lane == 5 ? cnt5 : lane == 6 ? cnt6 : cnt7; wcnt[F.wave * 8 + lane] = c; }
        __syncthreads();
        if (F.tid < 8) { int tot = 0;
#pragma unroll
            for (int w = 0; w < 8; ++w) tot += wcnt[w * 8 + F.tid];
            int run = (int)__hip_atomic_fetch_add((unsigned*)(F.ctl + CW_ECNT + 64 * F.tid), (unsigned)tot, RLX_AGENT);
#pragma unroll
            for (int w = 0; w < 8; ++w) { wbase[w * 8 + F.tid] = run; run += wcnt[w * 8 + F.tid]; } }
        __syncthreads();
        if (lane == 0) { int* rowtok = (int*)(F.ws + WS_ROWTOK); VM_WAIT();
            for (int m = gw; m < MTOK; m += NGW) { unsigned* rp = route + (size_t)m * 8; const int e0 = (int)rp[0], e1 = (int)rp[1];
                const int s0 = wbase[F.wave * 8 + e0]; wbase[F.wave * 8 + e0] = s0 + 1; const int s1 = wbase[F.wave * 8 + e1]; wbase[F.wave * 8 + e1] = s1 + 1;
                rp[2] = (unsigned)s0; rp[3] = (unsigned)s1; rowtok[e0 * MTOK + s0] = m; rowtok[e1 * MTOK + s1] = m; } }
    }
    __syncthreads();
}

__device__ __forceinline__ float fast_exp2(float x) { return __builtin_amdgcn_exp2f(x); }
__device__ __forceinline__ float logsig16(float x) { return (fminf(x, 0.f) - 0.6931471805599453f * __builtin_amdgcn_logf(1.f + fast_exp2(-fabsf(x) * LOG2E))) * 0.0625f; }
__device__ __forceinline__ void fox_cum_job(Frame& F, int bh) {
    const int b = bh >> 3, h = bh & 7, tid = F.tid; const float fb = F.in[6][h];
    const float* ff = (const float*)(F.ws + WS_FFGLR) + (size_t)(b * SEQ) * 24 + h;
    LAS float* wt = (LAS float*)F.lds;
    float v[8]; float run = 0.f;
    float xin[8];
#pragma unroll
    for (int i = 0; i < 8; ++i) xin[i] = ff[(size_t)(tid * 8 + i) * 24] + fb;
#pragma unroll
    for (int i = 0; i < 8; ++i) { run += 16.f * logsig16(xin[i]); v[i] = run; }
    float inc = run;
#pragma unroll
    for (int o = 1; o < 64; o <<= 1) { const float t = __shfl_up(inc, o); if (F.lane >= o) inc += t; }
    if (F.lane == 63) wt[F.wave] = inc;
    __syncthreads();
    float off = inc - run;
    for (int w = 0; w < F.wave; ++w) off += wt[w];
    float* cum = (float*)(F.ws + WS_CUM) + (size_t)bh * SEQ + tid * 8;
#pragma unroll
    for (int i = 0; i < 8; ++i) cum[i] = (off + v[i]) * LOG2E;
    __syncthreads();
}

__device__ __forceinline__ void fox_norm_job(Frame& F, int job) {
    const int bh = job >> 3, part = job & 7, b = bh >> 3, h = bh & 7, tok = b * SEQ + part * 512 + F.tid;
    const bf16_t* rowp = (const bf16_t*)(F.ws + WS_QKV) + (size_t)tok * NQKV + h * 64; float q2 = 0.f, k2 = 0.f;
#pragma unroll
    for (int i = 0; i < 8; ++i) { const u32x4 a = *(const u32x4*)(rowp + 8 * i), c = *(const u32x4*)(rowp + 512 + 8 * i);
        q2 += bf_lo(a.x) * bf_lo(a.x) + bf_hi(a.x) * bf_hi(a.x) + bf_lo(a.y) * bf_lo(a.y) + bf_hi(a.y) * bf_hi(a.y) + bf_lo(a.z) * bf_lo(a.z) + bf_hi(a.z) * bf_hi(a.z) + bf_lo(a.w) * bf_lo(a.w) + bf_hi(a.w) * bf_hi(a.w);
        k2 += bf_lo(c.x) * bf_lo(c.x) + bf_hi(c.x) * bf_hi(c.x) + bf_lo(c.y) * bf_lo(c.y) + bf_hi(c.y) * bf_hi(c.y) + bf_lo(c.z) * bf_lo(c.z) + bf_hi(c.z) * bf_hi(c.z) + bf_lo(c.w) * bf_lo(c.w) + bf_hi(c.w) * bf_hi(c.w); }
#pragma unroll
    for (int o = 1; o < 64; o <<= 1) { q2 = fmaxf(q2, __shfl_xor(q2, o)); k2 = fmaxf(k2, __shfl_xor(k2, o)); }
    LAS float* red = (LAS float*)F.lds;
    if (F.lane == 0) { red[2 * F.wave] = q2; red[2 * F.wave + 1] = k2; }
    __syncthreads();
    if (F.tid < 2) { float m = red[F.tid];
#pragma unroll
        for (int w = 1; w < 8; ++w) m = fmaxf(m, red[2 * w + F.tid]);
        ((float*)(F.ws + WS_QK2P))[2 * job + F.tid] = m; }
    __syncthreads();
}
constexpr int GL_ST = 72;
__device__ __forceinline__ bf16x8 lds_frag(const LAS bf16_t* X, int row, int k0) { return *(const LAS bf16x8*)(X + row * GL_ST + k0); }
struct Gla1In { f32x4 glr[4]; u32x4 k, v0, v1; };
__device__ __forceinline__ void gla1_load(Frame& F, int unit, Gla1In& I) {
    const int bh = unit >> 6, c = unit & 63, b = bh >> 2, hg = bh & 3, tok = b * SEQ + c * 64 + F.lane;
    const float* gp = (const float*)(F.ws + WS_FFGLR) + (size_t)tok * 24 + 8;
#pragma unroll
    for (int i = 0; i < 4; ++i) I.glr[i] = *(const f32x4*)(gp + 4 * i);
    const bf16_t* rp = (const bf16_t*)(F.ws + WS_QKV) + (size_t)tok * NQKV;
    I.k = *(const u32x4*)(rp + 1792 + hg * 64 + 8 * F.wave); I.v0 = *(const u32x4*)(rp + 2048 + hg * 128 + 16 * F.wave); I.v1 = *(const u32x4*)(rp + 2048 + hg * 128 + 16 * F.wave + 8);
}
__device__ __forceinline__ void gla1_phase(Frame& F) {
    LAS float* W2 = (LAS float*)F.lds;
    LAS float* B2 = W2 + 4096;
    LAS bf16_t* XAb = (LAS bf16_t*)(F.lds + 17408);
    LAS bf16_t* XVb = XAb + 2 * 64 * GL_ST;
    for (int i = F.tid; i < 4096; i += NTHR) W2[i] = F.in[7][i];
    if (F.tid < 256) B2[F.tid] = F.in[8][F.tid];
    int unit = blockIdx.x; if (unit >= 1024) { __syncthreads(); return; }
    Gla1In I; gla1_load(F, unit, I);
    __syncthreads();
    const int w = F.wave, lane = F.lane, r32 = lane & 31, hi = lane >> 5; int par = 0;
    float* Bbuf = (float*)(F.ws + WS_GLAB); float* ebuf = (float*)(F.ws + WS_GLAEB);
    for (;;) {
        const int hg = (unit >> 6) & 3; LAS bf16_t* XA = XAb + par * 64 * GL_ST; LAS bf16_t* XV = XVb + par * 128 * GL_ST;
        float bv[8];
        { const float g_[16] = {I.glr[0].x, I.glr[0].y, I.glr[0].z, I.glr[0].w, I.glr[1].x, I.glr[1].y, I.glr[1].z, I.glr[1].w, I.glr[2].x, I.glr[2].y, I.glr[2].z, I.glr[2].w, I.glr[3].x, I.glr[3].y, I.glr[3].z, I.glr[3].w};
            const LAS float* wp = W2 + hg * 64 + 8 * w; const f32x4 c0 = *(const LAS f32x4*)(B2 + hg * 64 + 8 * w), c1 = *(const LAS f32x4*)(B2 + hg * 64 + 8 * w + 4);
            float a[8] = {c0.x, c0.y, c0.z, c0.w, c1.x, c1.y, c1.z, c1.w};
#pragma unroll
            for (int r = 0; r < 16; ++r) { const f32x4 w0 = *(const LAS f32x4*)(wp + r * 256), w1 = *(const LAS f32x4*)(wp + r * 256 + 4);
                a[0] += g_[r] * w0.x; a[1] += g_[r] * w0.y; a[2] += g_[r] * w0.z; a[3] += g_[r] * w0.w; a[4] += g_[r] * w1.x; a[5] += g_[r] * w1.y; a[6] += g_[r] * w1.z; a[7] += g_[r] * w1.w; }
#pragma unroll
            for (int j = 0; j < 8; ++j) { float x = logsig16(a[j]);
#pragma unroll
                for (int o = 1; o < 64; o <<= 1) { const float t = __shfl_up(x, o); if (lane >= o) x += t; }
                bv[j] = x; } }
        float bl[8];
#pragma unroll
        for (int j = 0; j < 8; ++j) bl[j] = __shfl(bv[j], 63);
        { float* bp = Bbuf + ((size_t)unit * 64 + lane) * 64 + 8 * w; *(f32x4*)bp = (f32x4){bv[0], bv[1], bv[2], bv[3]}; *(f32x4*)(bp + 4) = (f32x4){bv[4], bv[5], bv[6], bv[7]}; }
        if (lane == 63) { float* ep = ebuf + (size_t)unit * 64 + 8 * w;
            *(f32x4*)ep = (f32x4){fast_exp2(bl[0] * LOG2E), fast_exp2(bl[1] * LOG2E), fast_exp2(bl[2] * LOG2E), fast_exp2(bl[3] * LOG2E)};
            *(f32x4*)(ep + 4) = (f32x4){fast_exp2(bl[4] * LOG2E), fast_exp2(bl[5] * LOG2E), fast_exp2(bl[6] * LOG2E), fast_exp2(bl[7] * LOG2E)}; }
        { const unsigned kw[4] = {I.k.x, I.k.y, I.k.z, I.k.w};
#pragma unroll
            for (int q = 0; q < 4; ++q) { const float k0 = bf_lo(kw[q]) * fast_exp2((bl[2 * q] - bv[2 * q]) * LOG2E), k1 = bf_hi(kw[q]) * fast_exp2((bl[2 * q + 1] - bv[2 * q + 1]) * LOG2E); const unsigned pk = cvt_pk_bf16(k0, k1);
                XA[(8 * w + 2 * q) * GL_ST + lane] = (bf16_t)(pk & 0xffffu); XA[(8 * w + 2 * q + 1) * GL_ST + lane] = (bf16_t)(pk >> 16); }
            const unsigned vw[8] = {I.v0.x, I.v0.y, I.v0.z, I.v0.w, I.v1.x, I.v1.y, I.v1.z, I.v1.w};
#pragma unroll
            for (int q = 0; q < 8; ++q) { XV[(16 * w + 2 * q) * GL_ST + lane] = (bf16_t)(vw[q] & 0xffffu); XV[(16 * w + 2 * q + 1) * GL_ST + lane] = (bf16_t)(vw[q] >> 16); } }
        const int nextu = unit + F.G; const bool more = nextu < 1024;
        if (more) gla1_load(F, nextu, I);
        LDS_BAR();
        { const int mb = w >> 2, nb = w & 3; f32x16 acc = {};
#pragma unroll
            for (int ks = 0; ks < 4; ++ks) acc = __builtin_amdgcn_mfma_f32_32x32x16_bf16(lds_frag(XA, mb * 32 + r32, ks * 16 + hi * 8), lds_frag(XV, nb * 32 + r32, ks * 16 + hi * 8), acc, 0, 0, 0);
            float* S = F.out + (size_t)unit * 8192;
#pragma unroll
            for (int r = 0; r < 16; ++r) S[(mb * 32 + (r & 3) + 8 * (r >> 2) + 4 * hi) * 128 + nb * 32 + r32] = acc[r]; }
        if (!more) break;
        unit = nextu; par ^= 1;
    }
    __syncthreads();
}
__device__ __forceinline__ void gla2_phase(Frame& F) {
    float* S = F.out; const float* eb = (const float*)(F.ws + WS_GLAEB);
    for (int e = blockIdx.x * NTHR + F.tid; e < 16 * 8192; e += F.G * NTHR) {
        const int bh = e >> 13, dv = e & 8191, d = dv >> 7; float st = 0.f;
        float* p = S + (size_t)bh * 64 * 8192 + dv; const float* q = eb + (size_t)bh * 64 * 64 + d;
#pragma unroll 8
        for (int c = 0; c < 64; ++c) { const float t = p[(size_t)c * 8192]; p[(size_t)c * 8192] = st; st = q[c * 64] * st + t; } }
}
struct Gla3In { f32x4 b0, b1; u32x4 q, k, v0, v1; f32x4 s[4]; u32x4 g0, g1; };
__device__ __forceinline__ void gla3_load(Frame& F, int unit, Gla3In& I) {
    const int bh = unit >> 6, c = unit & 63, b = bh >> 2, hg = bh & 3, tok0 = b * SEQ + c * 64, w = F.wave, lane = F.lane;
    const float* bp = (const float*)(F.ws + WS_GLAB) + ((size_t)unit * 64 + lane) * 64 + 8 * w; I.b0 = *(const f32x4*)bp; I.b1 = *(const f32x4*)(bp + 4);
    const bf16_t* rp = (const bf16_t*)(F.ws + WS_QKV) + (size_t)(tok0 + lane) * NQKV;
    I.q = *(const u32x4*)(rp + 1536 + hg * 64 + 8 * w); I.k = *(const u32x4*)(rp + 1792 + hg * 64 + 8 * w);
    I.v0 = *(const u32x4*)(rp + 2048 + hg * 128 + 16 * w); I.v1 = *(const u32x4*)(rp + 2048 + hg * 128 + 16 * w + 8);
    const float* sp = F.out + (size_t)unit * 8192 + lane * 128 + 16 * w;
#pragma unroll
    for (int i = 0; i < 4; ++i) I.s[i] = *(const f32x4*)(sp + 4 * i);
    const bf16_t* gp = (const bf16_t*)(F.ws + WS_QKV) + (size_t)(tok0 + (F.tid >> 3)) * NQKV + 2560 + hg * 128 + (F.tid & 7) * 16; I.g0 = *(const u32x4*)gp; I.g1 = *(const u32x4*)(gp + 8);
}
__device__ __forceinline__ void gla3_phase(Frame& F) {
    LAS bf16_t* XA = (LAS bf16_t*)F.lds;
    LAS bf16_t* XB = XA + 64 * GL_ST;
    LAS bf16_t* XV = XB + 64 * GL_ST;
    LAS bf16_t* XS = XV + 128 * GL_ST;
    LAS float* OL = (LAS float*)(F.lds + 55296);
    int unit = blockIdx.x; if (unit >= 1024) return;
    Gla3In I; gla3_load(F, unit, I);
    const int w = F.wave, lane = F.lane, r32 = lane & 31, hi = lane >> 5, tid = F.tid;
    for (;;) {
        const int bh = unit >> 6, c = unit & 63, b = bh >> 2, hg = bh & 3, tok0 = b * SEQ + c * 64;
        { const float bb[8] = {I.b0.x, I.b0.y, I.b0.z, I.b0.w, I.b1.x, I.b1.y, I.b1.z, I.b1.w}; const unsigned qw[4] = {I.q.x, I.q.y, I.q.z, I.q.w}, kw[4] = {I.k.x, I.k.y, I.k.z, I.k.w}; unsigned oq[4], ok[4];
#pragma unroll
            for (int q = 0; q < 4; ++q) { const float e0 = bb[2 * q] * LOG2E, e1 = bb[2 * q + 1] * LOG2E;
                oq[q] = cvt_pk_bf16(bf_lo(qw[q]) * 0.125f * fast_exp2(e0), bf_hi(qw[q]) * 0.125f * fast_exp2(e1)); ok[q] = cvt_pk_bf16(bf_lo(kw[q]) * fast_exp2(-e0), bf_hi(kw[q]) * fast_exp2(-e1)); }
            *(LAS u32x4*)(XA + lane * GL_ST + 8 * w) = (u32x4){oq[0], oq[1], oq[2], oq[3]}; *(LAS u32x4*)(XB + lane * GL_ST + 8 * w) = (u32x4){ok[0], ok[1], ok[2], ok[3]};
            const unsigned vw[8] = {I.v0.x, I.v0.y, I.v0.z, I.v0.w, I.v1.x, I.v1.y, I.v1.z, I.v1.w};
#pragma unroll
            for (int q = 0; q < 8; ++q) { XV[(16 * w + 2 * q) * GL_ST + lane] = (bf16_t)(vw[q] & 0xffffu); XV[(16 * w + 2 * q + 1) * GL_ST + lane] = (bf16_t)(vw[q] >> 16); }
#pragma unroll
            for (int q = 0; q < 4; ++q) { const unsigned p0 = cvt_pk_bf16(I.s[q].x, I.s[q].y), p1 = cvt_pk_bf16(I.s[q].z, I.s[q].w);
                XS[(16 * w + 4 * q) * GL_ST + lane] = (bf16_t)(p0 & 0xffffu); XS[(16 * w + 4 * q + 1) * GL_ST + lane] = (bf16_t)(p0 >> 16); XS[(16 * w + 4 * q + 2) * GL_ST + lane] = (bf16_t)(p1 & 0xffffu); XS[(16 * w + 4 * q + 3) * GL_ST + lane] = (bf16_t)(p1 >> 16); } }
        const u32x4 g0 = I.g0, g1 = I.g1;
        const int nextu = unit + F.G; const bool more = nextu < 1024;
        if (more) gla3_load(F, nextu, I);
        LDS_BAR();
        { const int mb = w >> 2, nb = w & 3; f32x16 o = {};
#pragma unroll
            for (int sb = 0; sb < 2; ++sb) { f32x16 st = {};
#pragma unroll
                for (int ks = 0; ks < 4; ++ks) st = __builtin_amdgcn_mfma_f32_32x32x16_bf16(lds_frag(XB, sb * 32 + r32, ks * 16 + hi * 8), lds_frag(XA, mb * 32 + r32, ks * 16 + hi * 8), st, 0, 0, 0);
                const int tq = mb * 32 + r32;
#pragma unroll
                for (int r = 0; r < 16; ++r) { const int sr = sb * 32 + (r & 3) + 8 * (r >> 2) + 4 * hi; st[r] = (sr <= tq) ? st[r] : 0.f; }
#pragma unroll
                for (int hf = 0; hf < 2; ++hf) {
                    const u32x4 pw = (u32x4){cvt_pk_bf16(st[8 * hf], st[8 * hf + 1]), cvt_pk_bf16(st[8 * hf + 2], st[8 * hf + 3]), cvt_pk_bf16(st[8 * hf + 4], st[8 * hf + 5]), cvt_pk_bf16(st[8 * hf + 6], st[8 * hf + 7])};
                    const LAS bf16_t* vp = XV + (nb * 32 + r32) * GL_ST + sb * 32 + 16 * hf + 4 * hi;
                    const u32x2 va = *(const LAS u32x2*)vp, vb = *(const LAS u32x2*)(vp + 8);
                    const u32x4 vf = (u32x4){va.x, va.y, vb.x, vb.y};
                    o = __builtin_amdgcn_mfma_f32_32x32x16_bf16(__builtin_bit_cast(bf16x8, pw), __builtin_bit_cast(bf16x8, vf), o, 0, 0, 0); } }
#pragma unroll
            for (int ks = 0; ks < 4; ++ks) o = __builtin_amdgcn_mfma_f32_32x32x16_bf16(lds_frag(XA, mb * 32 + r32, ks * 16 + hi * 8), lds_frag(XS, nb * 32 + r32, ks * 16 + hi * 8), o, 0, 0, 0);
#pragma unroll
            for (int r = 0; r < 16; ++r) OL[(mb * 32 + (r & 3) + 8 * (r >> 2) + 4 * hi) * 132 + nb * 32 + r32] = o[r]; }
        LDS_BAR();
        { const int t = tid >> 3, v0 = (tid & 7) * 16; float ov[16]; float ss = 0.f;
#pragma unroll
            for (int q = 0; q < 4; ++q) { const f32x4 x = *(const LAS f32x4*)(OL + t * 132 + v0 + 4 * q); ov[4 * q] = x.x; ov[4 * q + 1] = x.y; ov[4 * q + 2] = x.z; ov[4 * q + 3] = x.w; ss += (x.x * x.x + x.y * x.y) + (x.z * x.z + x.w * x.w); }
            ss += __shfl_xor(ss, 1); ss += __shfl_xor(ss, 2); ss += __shfl_xor(ss, 4);
            const float rinv = 1.f / sqrtf(ss * (1.f / 128.f) + EPS);
            const unsigned gw_[8] = {g0.x, g0.y, g0.z, g0.w, g1.x, g1.y, g1.z, g1.w}; const float* gn = F.in[9] + v0; unsigned ow[8];
#pragma unroll
            for (int q = 0; q < 8; ++q) { const float a = ov[2 * q] * rinv * gn[2 * q] * silu_f(bf_lo(gw_[q])), bb = ov[2 * q + 1] * rinv * gn[2 * q + 1] * silu_f(bf_hi(gw_[q])); ow[q] = cvt_pk_bf16(a, bb); }
            bf16_t* mp = (bf16_t*)(F.ws + WS_MIX) + (size_t)(tok0 + t) * 1024 + 512 + hg * 128 + v0;
            *(u32x4*)mp = (u32x4){ow[0], ow[1], ow[2], ow[3]}; *(u32x4*)(mp + 8) = (u32x4){ow[4], ow[5], ow[6], ow[7]}; }
        if (!more) break;
        unit = nextu;
    }
    __syncthreads();
}

__device__ __forceinline__ void s5_scan_job(Frame& F, int job) {
    const int g = job >> 2, b = job & 3, p = F.lane, seg = F.wave;
    const float* E = (const float*)(F.ws + WS_E) + ((size_t)(g * 512 + b * 128 + seg * 16)) * 128 + p;
    bf16_t* AU = (bf16_t*)(F.ws + WS_AU) + ((size_t)(g * 512 + b * 128 + seg * 16)) * 640 + 512 + p;
    const float* al = (const float*)(F.ws + WS_AL) + (size_t)(g * 64 + p) * 2; const float ar = al[0], ai = al[1];
    LAS float* se = (LAS float*)F.lds;
    float er[16], ei[16];
#pragma unroll
    for (int k = 0; k < 16; ++k) { er[k] = E[(size_t)k * 128]; ei[k] = E[(size_t)k * 128 + 64]; }
    float sr = 0.f, si = 0.f;
#pragma unroll
    for (int k = 0; k < 16; ++k) { const float nr = ar * sr - ai * si + er[k], ni = ar * si + ai * sr + ei[k]; sr = nr; si = ni; }
    se[(seg * 64 + p) * 2] = sr; se[(seg * 64 + p) * 2 + 1] = si;
    float pr = ar, pi = ai;
#pragma unroll
    for (int q = 0; q < 4; ++q) { const float nr = pr * pr - pi * pi, ni = 2.f * pr * pi; pr = nr; pi = ni; }
    __syncthreads();
    sr = 0.f; si = 0.f;
    for (int j = 0; j < seg; ++j) { const float xr = se[(j * 64 + p) * 2], xi = se[(j * 64 + p) * 2 + 1]; const float nr = pr * sr - pi * si + xr, ni = pr * si + pi * sr + xi; sr = nr; si = ni; }
#pragma unroll
    for (int k = 0; k < 16; ++k) { AU[(size_t)k * 640] = (bf16_t)f2bf(sr); AU[(size_t)k * 640 + 64] = (bf16_t)f2bf(si);
        const float nr = ar * sr - ai * si + er[k], ni = ar * si + ai * sr + ei[k]; sr = nr; si = ni; }
    __syncthreads();
}

__device__ __forceinline__ void moe_tile_starts(Frame& F, int* ts, int* cnt) {
    int run = 0;
#pragma unroll
    for (int e = 0; e < 8; ++e) { const int c = (int)__hip_atomic_load((unsigned*)(F.ctl + CW_ECNT + 64 * e), RLX_AGENT); cnt[e] = c; ts[e] = run; run += (c + 255) >> 8; }
    ts[8] = run;
}
template <bool MOE>
__device__ __forceinline__ void final_phase(Frame& F, const float* xsrc) {
    const int gw = F.vcu * NWAVES + F.wave, NGW = F.G * NWAVES, lane = F.lane;
    int ts[9], cnt[8]; if (MOE) moe_tile_starts(F, ts, cnt);
    const unsigned* route = (const unsigned*)(F.ws + WS_ROUTE); const bf16_t* yp = (const bf16_t*)(F.ws + WS_YPERM);
    const float* gate = (const float*)(F.ws + WS_MOD) + (size_t)3 * 4 * 3072 + 2048; const float* fw = F.in[38];
    for (int m = gw; m < MTOK; m += NGW) {
        const GAS f32x4* xr = (const GAS f32x4*)(xsrc + (size_t)m * 1024) + lane; f32x4 v[4];
#pragma unroll
        for (int j = 0; j < 4; ++j) v[j] = xr[64 * j];
        if (MOE) {
            const u32x4 r0 = *(const u32x4*)(route + (size_t)m * 8), r1 = *(const u32x4*)(route + (size_t)m * 8 + 4);
            const int e0 = (int)r0.x, e1 = (int)r0.y; const float w0 = __uint_as_float(r1.x), w1 = __uint_as_float(r1.y);
            int t0 = 0, t1 = 0;
#pragma unroll
            for (int e = 0; e < 8; ++e) { t0 = (e == e0) ? ts[e] : t0; t1 = (e == e1) ? ts[e] : t1; }
            const bf16_t* y0 = yp + (size_t)(t0 * 256 + (int)r0.z) * 1024, * y1 = yp + (size_t)(t1 * 256 + (int)r0.w) * 1024; const float* gv = gate + (size_t)(m >> 12) * 3072;
#pragma unroll
            for (int j = 0; j < 4; ++j) { const int c = 4 * lane + 256 * j; const u32x2 a = *(const u32x2*)(y0 + c), bq = *(const u32x2*)(y1 + c); const f32x4 gg = *(const f32x4*)(gv + c);
                v[j].x += gg.x * (w0 * bf_lo(a.x) + w1 * bf_lo(bq.x)); v[j].y += gg.y * (w0 * bf_hi(a.x) + w1 * bf_hi(bq.x)); v[j].z += gg.z * (w0 * bf_lo(a.y) + w1 * bf_lo(bq.y)); v[j].w += gg.w * (w0 * bf_hi(a.y) + w1 * bf_hi(bq.y)); }
        }
        float ss = 0.f;
#pragma unroll
        for (int j = 0; j < 4; ++j) ss += (v[j].x * v[j].x + v[j].y * v[j].y) + (v[j].z * v[j].z + v[j].w * v[j].w);
        const float rinv = 1.f / sqrtf(wave_sum(ss) * (1.f / 1024.f) + EPS);
        GAS f32x4* op = (GAS f32x4*)(F.out + (size_t)m * 1024) + lane;
#pragma unroll
        for (int j = 0; j < 4; ++j) { const f32x4 w = *(const f32x4*)(fw + 4 * lane + 256 * j); op[64 * j] = v[j] * rinv * w; }
    }
}
#ifndef MK_LAUNCH_PER_PHASE
#define MK_LAUNCH_PER_PHASE 0
#endif
#ifndef MK_STAGE
#define MK_STAGE 4
#endif
constexpr int NPHASE = 21;
struct Args { const float* in[39]; float* out; unsigned char* ws; int ph_lo, ph_hi; };
static_assert(sizeof(Args) == 39 * 8 + 8 + 8 + 8, "Args has no padding");

__global__ void __launch_bounds__(NTHR, 2) trunk_fwd(Args args) {
    extern __shared__ __attribute__((aligned(16))) unsigned char lds_raw[];
    Frame F;
    F.lds = (LAS unsigned char*)lds_raw;
    F.tid = threadIdx.x; F.lane = F.tid & 63; F.wave = __builtin_amdgcn_readfirstlane(F.tid >> 6);
    F.G = gridDim.x; { const int bx = blockIdx.x; F.vcu = (F.G % 8 == 0) ? (bx % 8) * (F.G / 8) + bx / 8 : bx; }
    F.ws = args.ws; F.out = args.out; F.ctl = (gu32*)(args.ws + WS_CTL);
    F.in = args.in;
    volatile LAS unsigned* MISC = (volatile LAS unsigned*)(F.lds + MISC_OFF);
    if (F.tid < 64) MISC[F.tid] = 0u;
    __syncthreads();
    if (!MK_LAUNCH_PER_PHASE) (void)xcd_barrier_post((unsigned*)(F.ctl + CW_BAR), MISC + 8);
#ifndef MK_ONLY
#define MK_ONLY -1
#endif
    const int lo = args.ph_lo, hi = args.ph_hi;
#define IN(k) ((MK_ONLY < 0 || (k) == MK_ONLY) && lo <= (k) && (k) < hi)
#if MK_LAUNCH_PER_PHASE
#define SEAM(k) do { } while (0)
#else
#define SEAM(k) do { XcdBarrier b_; b_.bar = (unsigned*)((gu32*)F.ws + CW_BAR); b_.x = xb_xcc_id(); b_.st = (volatile LAS unsigned*)(F.lds + MISC_OFF) + 8; xcd_barrier(b_); } while (0)
#endif
    unsigned char* ws = F.ws;
    const float* modv = (const float*)(ws + WS_MOD);
    bf16_t* const H = (bf16_t*)(ws + WS_H);
    const LAS unsigned* gtab = (const LAS unsigned*)(F.lds + GTAB_OFF);
    char* const ldsg = (char*)lds_raw;

    if (IN(0)) { p0_prologue(F); SEAM(0); }
#if MK_STAGE >= 1
    if (IN(1)) { norm_mod_phase<1>(F, F.in[0], F.in[2], modv + 0 * 12288, H); SEAM(1); }
    if (IN(2)) { pg8::Gemm g{H, (const bf16_t*)(ws + WS_WIN0), 1024, 1024, 1024, 0, 0}; pg8::StaticOrder S; S.init(MTOK / 256, NQKV / 256, 1, F.G, (int)blockIdx.x);
        pg8::EpiBf16 E{(bf16_t*)(ws + WS_QKV), NQKV, 2, attn_body::C2, 0};
        pg8::gemm_phase<pg8::EpiBf16, pg8::StaticOrder, true, false>(F.lds, g, S, E, gtab); SEAM(2); }
#ifndef MK_P3X
#define MK_P3X 0
#endif
    if (IN(3)) { for (int rep = 0; rep < (MK_P3X == 1 ? 2 : 1); ++rep) { for (int j = blockIdx.x; j < 256; j += F.G) fox_norm_job(F, j);
        for (int j = blockIdx.x; j < 32; j += F.G) fox_cum_job(F, j); }
        gla1_phase(F); if (MK_P3X == 2) gla1_phase(F); SEAM(3); }
    if (IN(4)) { if (blockIdx.x == 0 && F.tid == 0) __hip_atomic_store((unsigned*)(F.ctl + CW_AQ), 0u, RLX_AGENT);
        gla2_phase(F); SEAM(4); }
    if (IN(5)) { gla3_phase(F);
        const attn_body::bf16* qkv = (const attn_body::bf16*)(ws + WS_QKV);
        const attn_body::AttnTensors AT{qkv, qkv + 512, qkv + 1024, (attn_body::bf16*)(ws + WS_MIX), (const float*)(ws + WS_CUM), (const float*)(ws + WS_QK2P), (unsigned*)(F.ctl + CW_AQ)};
        attn_body::attn_phase<8>(ldsg, AT); SEAM(5); }
    if (IN(6)) { pg8::Gemm g{(const bf16_t*)(ws + WS_MIX), (const bf16_t*)(ws + WS_WO0), 1024, 1024, 1024, 0, 0}; pg8::StaticOrder S; S.init(MTOK / 256, 4, 1, F.G, (int)blockIdx.x);
        pg8::EpiResid E{F.in[0], F.out, modv + 0 * 12288 + 2048};
        pg8::gemm_phase<pg8::EpiResid, pg8::StaticOrder, false, false>(F.lds, g, S, E, gtab); SEAM(6); }
#endif
#if MK_STAGE >= 2
    if (IN(7)) { norm_mod_phase<0, MK_FP8 != 0>(F, F.out, F.in[11], modv + 1 * 12288, H); SEAM(7); }
    if (IN(8)) { pg8::Gemm g{H, (const bf16_t*)(ws + WS_WGU0), 1024, 1024, 1024, 0, 0}; pg8::StaticOrder S; S.init(MTOK / 256, 22, 1, F.G, (int)blockIdx.x);
        pg8::EpiSwiGLU E{(bf16_t*)(ws + WS_ACT), DFF, MK_FP8 ? 1.f / (FP8_ACT_SCALE * FP8_W_SCALE) : 1.f};
        pg8::gemm_phase<pg8::EpiSwiGLU, pg8::StaticOrder, true, false, MK_FP8 ? 1 : 2>(F.lds, g, S, E, gtab); SEAM(8); }
    if (IN(9)) { pg8::Gemm g{(const bf16_t*)(ws + WS_ACT), (const bf16_t*)(ws + WS_WD0), DFF, DFF, DFF, 0, 0}; pg8::StaticOrder S; S.init(MTOK / 256, 4, 1, F.G, (int)blockIdx.x);
        pg8::EpiResid E{F.out, F.out, modv + 1 * 12288 + 2048};
        pg8::gemm_phase<pg8::EpiResid, pg8::StaticOrder, false, false>(F.lds, g, S, E, gtab); SEAM(9); }
#endif
#if MK_STAGE >= 3
    if (IN(10)) { norm_mod_phase<0>(F, F.out, F.in[17], modv + 2 * 12288, H); SEAM(10); }
    if (IN(11)) { pg8::Gemm g{H, (const bf16_t*)(ws + WS_WIN1), 1024, 1024, 1024, 0, 0}; pg8::StaticOrder S; S.init(MTOK / 256, 4, 1, F.G, (int)blockIdx.x);
        pg8::EpiS5U E{(bf16_t*)(ws + WS_AU)};
        pg8::gemm_phase<pg8::EpiS5U, pg8::StaticOrder, false, false>(F.lds, g, S, E, gtab); SEAM(11); }
    if (IN(12)) { pg8::Gemm g{(const bf16_t*)(ws + WS_AU), (const bf16_t*)(ws + WS_S5WA), 640, 512, 512, (size_t)512 * 640, (size_t)256 * 512}; pg8::StaticOrder S; S.init(2, 1, 64, F.G, (int)blockIdx.x);
        pg8::EpiS5E E{(float*)(ws + WS_E)};
        pg8::gemm_phase<pg8::EpiS5E, pg8::StaticOrder, false, false>(F.lds, g, S, E, gtab); SEAM(12); }
    if (IN(13)) { for (int j = blockIdx.x; j < 256; j += F.G) s5_scan_job(F, j); SEAM(13); }
    if (IN(14)) { pg8::Gemm g{(const bf16_t*)(ws + WS_AU), (const bf16_t*)(ws + WS_S5T), 640, 640, 640, (size_t)512 * 640, (size_t)512 * 640}; pg8::StaticOrder S; S.init(2, 2, 64, F.G, (int)blockIdx.x);
        pg8::EpiS5Y E{(const bf16_t*)(ws + WS_AU), F.in[28], (bf16_t*)(ws + WS_YG)};
        pg8::gemm_phase<pg8::EpiS5Y, pg8::StaticOrder, false, false>(F.lds, g, S, E, gtab); SEAM(14); }
    if (IN(15)) { pg8::Gemm g{(const bf16_t*)(ws + WS_YG), (const bf16_t*)(ws + WS_WGLU), 1024, 1024, 1024, 0, 0}; pg8::StaticOrder S; S.init(MTOK / 256, 4, 1, F.G, (int)blockIdx.x);
        pg8::EpiGlu E{(const bf16_t*)(ws + WS_YG), (bf16_t*)(ws + WS_Z)};
        pg8::gemm_phase<pg8::EpiGlu, pg8::StaticOrder, false, false>(F.lds, g, S, E, gtab); SEAM(15); }
    if (IN(16)) { pg8::Gemm g{(const bf16_t*)(ws + WS_Z), (const bf16_t*)(ws + WS_WO1), 1024, 1024, 1024, 0, 0}; pg8::StaticOrder S; S.init(MTOK / 256, 4, 1, F.G, (int)blockIdx.x);
        pg8::EpiResid E{F.out, F.out, modv + 2 * 12288 + 2048};
        pg8::gemm_phase<pg8::EpiResid, pg8::StaticOrder, false, false>(F.lds, g, S, E, gtab); SEAM(16); }
#endif
#if MK_STAGE >= 4
    if (IN(17)) { norm_mod_phase<2, MK_FP8 != 0>(F, F.out, F.in[31], modv + 3 * 12288, (bf16_t*)(ws + WS_H3)); SEAM(17); }
    if (IN(18)) { int ts[9], cnt[8]; moe_tile_starts(F, ts, cnt);
        pg8::MoeOrder S; S.init(ts, 22, F.G, (int)blockIdx.x, 1, 0);
        {
            LAS unsigned* gt = (LAS unsigned*)(F.lds + GTAB_OFF); const int* rowtok = (const int*)(ws + WS_ROWTOK); pg8::Unit u;
            for (int i = 0; i < 16 && S.next(i, u); ++i) if (F.tid < 256) { int base = 0, c = 0;
#pragma unroll
                for (int e = 0; e < 8; ++e) { base = (u.bt == e) ? ts[e] : base; c = (u.bt == e) ? cnt[e] : c; }
                const int sl = (u.pm - base) * 256 + F.tid; const int tok = (sl < c) ? rowtok[u.bt * MTOK + sl] : 0; gt[i * 256 + F.tid] = (unsigned)tok * (MK_FP8 ? 1024u : 2048u); }
            __syncthreads(); }
        pg8::Gemm g{(const bf16_t*)(ws + WS_H3), (const bf16_t*)(ws + WS_WEGU), 1024, 1024, 1024, 0, (size_t)5632 * 1024};
        pg8::EpiSwiGLU E{(bf16_t*)(ws + WS_ACTP), DFF, MK_FP8 ? 1.f / (FP8_ACT_SCALE * FP8_W_SCALE) : 1.f};
        pg8::gemm_phase<pg8::EpiSwiGLU, pg8::MoeOrder, true, true, MK_FP8 ? 1 : 2>(F.lds, g, S, E, gtab); SEAM(18); }
    if (IN(19)) { int ts[9], cnt[8]; moe_tile_starts(F, ts, cnt);
        pg8::MoeOrder S; S.init(ts, 4, F.G, (int)blockIdx.x, 1, 0);
        pg8::Gemm g{(const bf16_t*)(ws + WS_ACTP), (const bf16_t*)(ws + WS_WED), DFF, DFF, DFF, 0, (size_t)1024 * DFF};
        pg8::EpiBf16 E{(bf16_t*)(ws + WS_YPERM), 1024, 0, 1.f, (size_t)(WS_YPERM2 - WS_YPERM) / 2};
        pg8::gemm_phase<pg8::EpiBf16, pg8::MoeOrder, false, false>(F.lds, g, S, E, gtab); SEAM(19); }
#endif
    if (IN(20)) {
#if MK_STAGE >= 4
        final_phase<true>(F, F.out);
#elif MK_STAGE >= 1
        final_phase<false>(F, F.out);
#else
        final_phase<false>(F, F.in[0]);
#endif
    }
#undef IN
#undef SEAM
}

extern "C" void kernel_launch(void* const* d_in, const int* in_sizes, int n_in, void* d_out, int out_size, void* d_ws, size_t ws_size, hipStream_t stream) {
    static int grid = 0;
    if (grid == 0) {
        if (n_in != 39 || in_sizes[0] != MTOK * DMODEL || out_size != MTOK * DMODEL || ws_size < WS_END) {
            fprintf(stderr, "kernel_launch: shape/workspace mismatch: n_in %d in0 %d out %d ws %zu (need %zu); nothing launched\n", n_in, n_in > 0 ? in_sizes[0] : -1, out_size, ws_size, (size_t)WS_END); grid = -1; return; }
        int dev = 0, cus = 0, per_cu = 0;
        if (hipGetDevice(&dev) != hipSuccess || hipDeviceGetAttribute(&cus, hipDeviceAttributeMultiprocessorCount, dev) != hipSuccess) { grid = -1; return; }
        if (hipFuncSetAttribute((const void*)trunk_fwd, hipFuncAttributeMaxDynamicSharedMemorySize, LDS_BYTES) != hipSuccess) { fprintf(stderr, "kernel_launch: hipFuncSetAttribute failed\n"); grid = -1; return; }
        if (hipOccupancyMaxActiveBlocksPerMultiprocessor(&per_cu, (const void*)trunk_fwd, NTHR, LDS_BYTES) != hipSuccess || per_cu < 1)
            fprintf(stderr, "kernel_launch: note: occupancy query reports %d workgroups per CU\n", per_cu);
        (void)hipGetLastError();
        grid = cus;
    }
    if (grid < 0) return;
    if (hipMemsetAsync((char*)d_ws + WS_CTL, 0, CTL_ZERO_BYTES, stream) != hipSuccess) return;
    Args a{};
    for (int i = 0; i < 39; ++i) a.in[i] = (const float*)d_in[i];
    a.out = (float*)d_out; a.ws = (unsigned char*)d_ws;
#if MK_LAUNCH_PER_PHASE
    for (int p = 0; p < NPHASE; ++p) { a.ph_lo = p; a.ph_hi = p + 1; hipLaunchKernelGGL(trunk_fwd, dim3(grid), dim3(NTHR), LDS_BYTES, stream, a);
#if defined(MK_DUP_A) && defined(MK_DUP_B)
        if (p == MK_DUP_B) for (int q = MK_DUP_A; q <= MK_DUP_B; ++q) { a.ph_lo = q; a.ph_hi = q + 1; hipLaunchKernelGGL(trunk_fwd, dim3(grid), dim3(NTHR), LDS_BYTES, stream, a); }
#endif
    }
#else
    a.ph_lo = 0; a.ph_hi = NPHASE; hipLaunchKernelGGL(trunk_fwd, dim3(grid), dim3(NTHR), LDS_BYTES, stream, a);
#endif
}
```
